# Optimizing an MI355X kernel written in HIP

```python
import math
import jax, jax.numpy as jnp
from jax import lax
import numpy as np

D_MODEL = 1024
BATCH = 4
SEQ = 4096
DEPTH = 4
DEC_BATCH = 128
DEC_SEQ = 1
PAST_LEN = 8192
PAGE_SIZE = 128

N_MIXERS = 2
N_RET = (DEPTH + 1) // 2
N_SWA = DEPTH // 2

RET_HEADS = 4
RET_DK = 256
RET_DV = 512
RET_QK = RET_HEADS * RET_DK
RET_V = RET_HEADS * RET_DV
RET_IN = 2 * RET_QK + 2 * RET_V
RET_CHUNK = 128

SWA_HEADS = 16
SWA_KV_HEADS = 2
SWA_GROUP = SWA_HEADS // SWA_KV_HEADS
SWA_HD = 64
SWA_Q = SWA_HEADS * SWA_HD
SWA_KV = SWA_KV_HEADS * SWA_HD
SWA_IN = 2 * SWA_Q + 2 * SWA_KV
WINDOW = 128
SWA_BLOCK = WINDOW

EPS = 1e-6
NEG = -1e30

kernel_name = "hybrid_retention_swa_decode_step"


def rmsnorm(x, g):
    xf = x.astype(jnp.float32)
    y = xf * lax.rsqrt(jnp.mean(xf * xf, axis=-1, keepdims=True) + EPS)
    return (y * g.astype(jnp.float32)).astype(x.dtype)


def retention_scan(q, k, v, S0):
    B, L = q.shape[0], q.shape[1]
    C = RET_CHUNK if L % RET_CHUNK == 0 else L
    n = L // C
    log_g = jnp.log(1.0 - jnp.exp2(-5.0 - jnp.arange(RET_HEADS, dtype=jnp.float32)))
    idx = jnp.arange(C, dtype=jnp.float32)
    dist = idx[:, None] - idx[None, :]
    dmask = jnp.where(dist[None] >= 0, jnp.exp(log_g[:, None, None] * jnp.maximum(dist, 0.0)[None]), 0.0)
    cross_decay = jnp.exp(log_g[None, :] * (idx[:, None] + 1.0))
    k_decay = jnp.exp(log_g[None, :] * (C - 1.0 - idx[:, None]))
    chunk_decay = jnp.exp(log_g * C)

    def to_chunks(a):
        a = a.astype(jnp.float32).reshape(B, n, C, a.shape[2], a.shape[3])
        return jnp.moveaxis(a, 1, 0)

    def step(S, inp):
        qc, kc, vc = inp
        inner = jnp.einsum('bthd,bshd->bhts', qc, kc) * dmask[None]
        o = jnp.einsum('bhts,bshe->bthe', inner, vc) \
            + jnp.einsum('bthd,bhde->bthe', qc, S) * cross_decay[None, :, :, None]
        S_new = S * chunk_decay[None, :, None, None] \
            + jnp.einsum('bshd,bshe->bhde', kc * k_decay[None, :, :, None], vc)
        return S_new, o

    S_fin, o = lax.scan(step, S0.astype(jnp.float32), (to_chunks(q), to_chunks(k), to_chunks(v)))
    o = jnp.moveaxis(o, 0, 1).reshape(B, L, RET_HEADS, RET_DV)
    return o.astype(v.dtype), S_fin


def retention_layer(x, S0, g_norm, w_in, g_out, w_out):
    B, L, _ = x.shape
    h = rmsnorm(x, g_norm)
    proj = h @ w_in
    q, k, v, gate = jnp.split(proj, [RET_QK, 2 * RET_QK, 2 * RET_QK + RET_V], axis=-1)
    q = q.reshape(B, L, RET_HEADS, RET_DK)
    k = k.reshape(B, L, RET_HEADS, RET_DK) * (RET_DK ** -0.5)
    v = v.reshape(B, L, RET_HEADS, RET_DV)
    o, S = retention_scan(q, k, v, S0)
    o = rmsnorm(o, g_out.reshape(RET_HEADS, RET_DV)).reshape(B, L, RET_V)
    o = o * jax.nn.silu(gate)
    return x + o @ w_out, S.astype(S0.dtype)


def alibi_slopes():
    h = jnp.arange(1, SWA_HEADS + 1, dtype=jnp.float32)
    return jnp.exp2(-8.0 * h / SWA_HEADS).reshape(SWA_KV_HEADS, SWA_GROUP)


def sink_softmax(scores, sinks):
    sink_col = jnp.broadcast_to(sinks.astype(jnp.float32)[:, :, None, None], scores.shape[:-1] + (1,))
    p = jax.nn.softmax(jnp.concatenate([scores, sink_col], axis=-1), axis=-1)
    return p[..., :-1]


def swa_attend_prompt(q, k, v, sinks):
    B, L = q.shape[0], q.shape[1]
    nb = L // SWA_BLOCK
    qb = q.reshape(B, nb, SWA_BLOCK, SWA_KV_HEADS, SWA_GROUP, SWA_HD)

    def band(a):
        pad = jnp.zeros((B, SWA_BLOCK) + a.shape[2:], a.dtype)
        prev = jnp.concatenate([pad, a[:, :L - SWA_BLOCK]], axis=1).reshape(B, nb, SWA_BLOCK, SWA_KV_HEADS, SWA_HD)
        cur = a.reshape(B, nb, SWA_BLOCK, SWA_KV_HEADS, SWA_HD)
        return jnp.concatenate([prev, cur], axis=2)

    kk, vv = band(k), band(v)
    scores = jnp.einsum('bnqkgd,bnskd->bnkgqs', qb, kk).astype(jnp.float32) * (SWA_HD ** -0.5)
    j = jnp.arange(SWA_BLOCK)[:, None]
    u = jnp.arange(2 * SWA_BLOCK)[None, :]
    dist = SWA_BLOCK + j - u
    in_band = (dist >= 0) & (dist <= WINDOW)
    valid = in_band[None] & ((jnp.arange(nb)[:, None, None] > 0) | (u[None] >= SWA_BLOCK))
    scores = scores - alibi_slopes()[:, :, None, None] * dist.astype(jnp.float32)
    scores = jnp.where(valid[None, :, None, None], scores, NEG)
    p = sink_softmax(scores, sinks).astype(v.dtype)
    o = jnp.einsum('bnkgqs,bnskd->bnqkgd', p, vv)
    return o.reshape(B, L, SWA_Q)


def swa_attend_sample(q, k, v, k_buf, v_buf, sinks):
    B, T = q.shape[0], q.shape[1]
    Wb = k_buf.shape[1]
    kk = jnp.concatenate([k_buf, k], axis=1)
    vv = jnp.concatenate([v_buf, v], axis=1)
    scores = jnp.einsum('btkgd,bskd->bkgts', q, kk).astype(jnp.float32) * (SWA_HD ** -0.5)
    dist = Wb + jnp.arange(T)[:, None] - jnp.arange(Wb + T)[None, :]
    valid = (dist >= 0) & (dist <= WINDOW)
    scores = scores - alibi_slopes()[:, :, None, None] * dist.astype(jnp.float32)
    scores = jnp.where(valid, scores, NEG)
    p = sink_softmax(scores, sinks).astype(v.dtype)
    o = jnp.einsum('bkgts,bskd->btkgd', p, vv).reshape(B, T, SWA_Q)
    return o, kk[:, -Wb:], vv[:, -Wb:]


def swa_layer(x, g_norm, w_in, q_gain, k_gain, sinks, w_out, k_buf=None, v_buf=None):
    B, L, _ = x.shape
    h = rmsnorm(x, g_norm)
    proj = h @ w_in
    q, k, v, gate = jnp.split(proj, [SWA_Q, SWA_Q + SWA_KV, SWA_Q + 2 * SWA_KV], axis=-1)
    q = rmsnorm(q.reshape(B, L, SWA_KV_HEADS, SWA_GROUP, SWA_HD), q_gain)
    k = rmsnorm(k.reshape(B, L, SWA_KV_HEADS, SWA_HD), k_gain)
    v = v.reshape(B, L, SWA_KV_HEADS, SWA_HD)
    if k_buf is None:
        o = swa_attend_prompt(q, k, v, sinks)
        w = min(WINDOW, L)
        new_k, new_v = k[:, L - w:], v[:, L - w:]
    else:
        o, new_k, new_v = swa_attend_sample(q, k, v, k_buf, v_buf, sinks)
    o = o * jax.nn.silu(gate)
    return x + o @ w_out, new_k, new_v


def setup_inputs(seed: int = 0) -> dict:
    key = jax.random.key(seed)
    ks = jax.random.split(key, 16)
    f32 = jnp.float32
    wb = min(WINDOW, PAST_LEN)
    nrm = lambda k, s: jax.random.normal(k, s, f32)
    return {
        "x_prompt": nrm(ks[0], (BATCH, SEQ, D_MODEL)),
        "x_sample": nrm(ks[1], (DEC_BATCH, DEC_SEQ, D_MODEL)),
        "state_ret": nrm(ks[2], (N_RET, DEC_BATCH, RET_HEADS, RET_DK, RET_DV)) * 0.1,
        "cache_swa_k": nrm(ks[3], (N_SWA, DEC_BATCH, wb, SWA_KV_HEADS, SWA_HD)),
        "cache_swa_v": nrm(ks[4], (N_SWA, DEC_BATCH, wb, SWA_KV_HEADS, SWA_HD)),
        "norm_ret": 1.0 + 0.02 * nrm(ks[5], (N_RET, D_MODEL)),
        "w_in_ret": nrm(ks[6], (N_RET, D_MODEL, RET_IN)) * D_MODEL ** -0.5,
        "ret_out_norm": 1.0 + 0.02 * nrm(ks[7], (N_RET, RET_V)),
        "w_out_ret": nrm(ks[8], (N_RET, RET_V, D_MODEL)) * RET_V ** -0.5,
        "norm_swa": 1.0 + 0.02 * nrm(ks[9], (N_SWA, D_MODEL)),
        "w_in_swa": nrm(ks[10], (N_SWA, D_MODEL, SWA_IN)) * D_MODEL ** -0.5,
        "q_norm": 1.0 + 0.02 * nrm(ks[11], (N_SWA, SWA_HD)),
        "k_norm": 1.0 + 0.02 * nrm(ks[12], (N_SWA, SWA_HD)),
        "sinks": 0.5 * nrm(ks[13], (N_SWA, SWA_KV_HEADS, SWA_GROUP)),
        "w_out_swa": nrm(ks[14], (N_SWA, SWA_Q, D_MODEL)) * SWA_Q ** -0.5,
    }


def reference(x_prompt, x_sample, state_ret, cache_swa_k, cache_swa_v,
              norm_ret, w_in_ret, ret_out_norm, w_out_ret,
              norm_swa, w_in_swa, q_norm, k_norm, sinks, w_out_swa):
    xp, xs = x_prompt, x_sample
    ret_p, ret_s, kp_l, vp_l, ks_l, vs_l = [], [], [], [], [], []
    for i in range(DEPTH):
        li = i // N_MIXERS
        if i % N_MIXERS == 0:
            S0p = jnp.zeros((xp.shape[0], RET_HEADS, RET_DK, RET_DV), xp.dtype)
            xp, Sp = retention_layer(xp, S0p, norm_ret[li], w_in_ret[li], ret_out_norm[li], w_out_ret[li])
            xs, Ss = retention_layer(xs, state_ret[li], norm_ret[li], w_in_ret[li], ret_out_norm[li], w_out_ret[li])
            ret_p.append(Sp)
            ret_s.append(Ss)
        else:
            xp, kp, vp = swa_layer(xp, norm_swa[li], w_in_swa[li], q_norm[li], k_norm[li], sinks[li], w_out_swa[li])
            xs, kS, vS = swa_layer(xs, norm_swa[li], w_in_swa[li], q_norm[li], k_norm[li], sinks[li], w_out_swa[li],
                                   cache_swa_k[li], cache_swa_v[li])
            kp_l.append(kp); vp_l.append(vp); ks_l.append(kS); vs_l.append(vS)
    return (xp, xs, jnp.stack(ret_p), jnp.stack(ret_s), jnp.stack(kp_l), jnp.stack(vp_l), jnp.stack(ks_l), jnp.stack(vs_l))
```

```cpp
#include <hip/hip_runtime.h>
#include <hip/hip_cooperative_groups.h>
#include <cstdio>
#include <cstdint>
namespace cg = cooperative_groups;

#define LAS __attribute__((address_space(3)))
typedef unsigned short bf16_t;
typedef short bf16x8 __attribute__((ext_vector_type(8)));
typedef short s16x4 __attribute__((ext_vector_type(4)));
typedef float f32x4 __attribute__((ext_vector_type(4)));
typedef float f32x2 __attribute__((ext_vector_type(2)));
typedef unsigned u32x4 __attribute__((ext_vector_type(4)));
typedef unsigned u32x2 __attribute__((ext_vector_type(2)));

constexpr int D = 1024, MP = 16384, MS = 128, MT = 16640, SEQ = 4096;
constexpr int RET_IN = 6144, SWA_IN = 2304, RET_V = 2048;
constexpr float EPS = 1e-6f;
constexpr float LOG2E = 1.4426950408889634f;

constexpr size_t O_YP = 0, O_YS = 16777216, O_RETP = 16908288, O_RETS = 21102592, O_KP = 155320320, O_VP = 155451392, O_KS = 155582464, O_VS = 159776768, O_END = 163971072;

constexpr size_t MiB = 1u << 20;
constexpr size_t WS_WIN_RET = 0, WS_WOUT_RET = 24 * MiB, WS_WIN_SWA = 32 * MiB, WS_WOUT_SWA = 41 * MiB, WS_H = 48 * MiB, WS_PROJ = 96 * MiB,
                 WS_P = 292 * MiB, WS_O = 308 * MiB, WS_OG = 376 * MiB, WS_BAR = 447 * MiB,
                 WS_QB = 448 * MiB  , WS_KB = 480 * MiB  , WS_VB = 512 * MiB  , WS_END = 576 * MiB;
constexpr int LDS_BYTES = 163840, MISC_OFF = 163840 - 256;

__device__ __forceinline__ unsigned cvt_pk_bf16(float lo, float hi) { unsigned r; asm volatile("v_cvt_pk_bf16_f32 %0, %1, %2" : "=v"(r) : "v"(lo), "v"(hi)); return r; }
__device__ __forceinline__ float bf_lo(unsigned u) { return __builtin_bit_cast(float, u << 16); }
__device__ __forceinline__ float bf_hi(unsigned u) { return __builtin_bit_cast(float, u & 0xffff0000u); }
__device__ __forceinline__ float bf2f(bf16_t b) { return __builtin_bit_cast(float, ((unsigned)b) << 16); }
__device__ __forceinline__ float wave_sum(float v) {
#pragma unroll
    for (int o = 1; o < 64; o <<= 1) v += __shfl_xor(v, o);
    return v;
}
__device__ __forceinline__ float wave_max(float v) {
#pragma unroll
    for (int o = 1; o < 64; o <<= 1) v = fmaxf(v, __shfl_xor(v, o));
    return v;
}
__device__ __forceinline__ float silu(float x) { return x / (1.f + __expf(-x)); }
__device__ __forceinline__ s16x4 tr_read(const LAS unsigned char* p) {
    typedef short v4i16_t __attribute__((ext_vector_type(4)));
    return __builtin_bit_cast(s16x4, __builtin_amdgcn_ds_read_tr16_b64_v4i16((LAS v4i16_t*)p));
}
__device__ __forceinline__ bf16x8 cat8(s16x4 a, s16x4 b) { bf16x8 r; r[0] = a[0]; r[1] = a[1]; r[2] = a[2]; r[3] = a[3]; r[4] = b[0]; r[5] = b[1]; r[6] = b[2]; r[7] = b[3]; return r; }
__device__ __forceinline__ bf16x8 pack8(float a0, float a1, float a2, float a3, float a4, float a5, float a6, float a7) {
    u32x4 w; w.x = cvt_pk_bf16(a0, a1); w.y = cvt_pk_bf16(a2, a3); w.z = cvt_pk_bf16(a4, a5); w.w = cvt_pk_bf16(a6, a7); return __builtin_bit_cast(bf16x8, w);
}
#define LDS_BARRIER() do { asm volatile("s_waitcnt lgkmcnt(0)" ::: "memory"); __builtin_amdgcn_s_barrier(); asm volatile("" ::: "memory"); } while (0)
#define MFMA16(a, b, c) __builtin_amdgcn_mfma_f32_16x16x32_bf16((a), (b), (c), 0, 0, 0)

namespace pg8 {
#define PG8_LAS __attribute__((address_space(3)))
constexpr int BM = 256, BK = 64, HALF = 128, HTB = HALF * BK * 2, STAGE_BYTES = 8 * HTB, NXCD = 8, WGM = 8;
__host__ __device__ __forceinline__ int lds_byte(int r, int c) { const int st = (r >> 4) * 2 + (c >> 5), rr = r & 15, cc = c & 31, ob = rr * 64 + cc * 2; return st * 1024 + (ob ^ (((ob >> 9) & 1) << 5)); }
__host__ __device__ __forceinline__ void stage_rc(int b, int& R, int& C) { const int st = b / 1024, sb = b % 1024, swz = sb ^ (((sb >> 9) & 1) << 5); R = (st >> 1) * 16 + swz / 64; C = (st & 1) * 32 + (swz % 64) / 2; }
__host__ __device__ __forceinline__ int perm32(int rho) { const int n = rho >> 4, i = rho & 15; return 8 * (i >> 2) + 4 * n + (i & 3); }
struct Unit { int pm, pn; };
struct Gemm { const bf16_t* A; const bf16_t* Bt; int M, N, K; };
struct StaticOrder {
    int nM, nN, nwg, G, c;
    __host__ __device__ void init(int M, int N, int G_, int c_) { nM = M / BM; nN = N / BM; nwg = nM * nN; G = G_; c = c_; }
    __host__ __device__ bool next(int i, Unit& u) const {
        const long L = (long)i * G + c; if (L >= nwg) return false;
        int wgid = (int)L; { const int q = nwg / NXCD, r = nwg % NXCD, xcd = wgid % NXCD, off = wgid / NXCD; wgid = (xcd < r ? xcd * (q + 1) : r * (q + 1) + (xcd - r) * q) + off; }
        const int nig = WGM * nN, gid = wgid / nig, fm = gid * WGM, gsz = (nM - fm) < WGM ? (nM - fm) : WGM;
        u.pm = fm + ((wgid % nig) % gsz); u.pn = (wgid % nig) / gsz; return true;
    }
    __device__ __forceinline__ void a_ready(const Unit&) const {}
    __device__ __forceinline__ void done(const Unit&) const {}
};
struct EpiProj {
    static constexpr bool PERM = true;
    bf16_t* O; int ldc; int sc_lo, sc_hi; float scale;
    __device__ __forceinline__ void operator()(const f32x4 (&acc)[2][2][4][2], const Unit& u, int wr, int wc, int fr, int fq) const {
        const int row0 = u.pm * BM + wr * 64 + fr; const int col0 = u.pn * BM + wc * 32 + 8 * fq;
        const float sc = (u.pn >= sc_lo && u.pn < sc_hi) ? scale : 1.f;
#pragma unroll
        for (int ai = 0; ai < 2; ++ai)
#pragma unroll
            for (int m = 0; m < 4; ++m) { bf16_t* rowp = O + (size_t)(row0 + ai * HALF + m * 16) * ldc + col0;
#pragma unroll
                for (int bj = 0; bj < 2; ++bj) { f32x4 v0 = acc[ai][bj][m][0] * sc, v1 = acc[ai][bj][m][1] * sc;
                    u32x4 w; w.x = cvt_pk_bf16(v0[0], v0[1]); w.y = cvt_pk_bf16(v0[2], v0[3]); w.z = cvt_pk_bf16(v1[0], v1[1]); w.w = cvt_pk_bf16(v1[2], v1[3]);
                    *(u32x4*)(rowp + bj * HALF) = w; } }
    }
};
struct EpiProjRet {
    static constexpr bool PERM = true;
    bf16_t* QB; bf16_t* KB; bf16_t* VB; bf16_t* G; int ldg;
    __device__ __forceinline__ void operator()(const f32x4 (&acc)[2][2][4][2], const Unit& u, int wr, int wc, int fr, int fq) const {
        const int pn = u.pn, t0 = wr * 64 + fr; const size_t tile0 = (size_t)((u.pm >> 4) * 32 + ((u.pm & 15) << 1)) * 4;
        const float sc = (pn >= 4 && pn < 8) ? 0.0625f : 1.f;
        bf16_t* base; size_t sa; int sm, sbj;
        if (pn < 8) { base = (pn < 4 ? QB : KB) + (tile0 + (pn & 3)) * 32768 + t0 * 256 + wc * 32 + 8 * fq; sa = 4 * 32768; sm = 16 * 256; sbj = HALF; }
        else if (pn < 16) { base = VB + ((tile0 + ((pn - 8) >> 1)) * 8 + (pn & 1) * 4 + (wc >> 1)) * 8192 + t0 * 64 + 32 * (wc & 1) + 8 * fq; sa = 4 * 8 * 8192; sm = 16 * 64; sbj = 2 * 8192; }
        else { base = G + (size_t)(u.pm * BM + t0) * ldg + pn * BM + wc * 32 + 8 * fq; sa = (size_t)HALF * ldg; sm = 16 * ldg; sbj = HALF; }
#pragma unroll
        for (int ai = 0; ai < 2; ++ai)
#pragma unroll
            for (int m = 0; m < 4; ++m) { bf16_t* rowp = base + ai * sa + (size_t)m * sm;
#pragma unroll
                for (int bj = 0; bj < 2; ++bj) { f32x4 v0 = acc[ai][bj][m][0] * sc, v1 = acc[ai][bj][m][1] * sc;
                    u32x4 w; w.x = cvt_pk_bf16(v0[0], v0[1]); w.y = cvt_pk_bf16(v0[2], v0[3]); w.z = cvt_pk_bf16(v1[0], v1[1]); w.w = cvt_pk_bf16(v1[2], v1[3]);
                    *(u32x4*)(rowp + bj * sbj) = w; } }
    }
};
struct EpiRes {
    static constexpr bool PERM = false;
    const float* X; float* Y; int ldc;
    __device__ __forceinline__ void operator()(const f32x4 (&acc)[2][2][4][2], const Unit& u, int wr, int wc, int fr, int fq) const {
        const int row0 = u.pm * BM + wr * 64 + fr, col0 = u.pn * BM + wc * 32 + 4 * fq;
#pragma unroll
        for (int ai = 0; ai < 2; ++ai)
#pragma unroll
            for (int m = 0; m < 4; ++m) { const size_t ro = (size_t)(row0 + ai * HALF + m * 16) * ldc + col0;
#pragma unroll
                for (int bj = 0; bj < 2; ++bj)
#pragma unroll
                    for (int n = 0; n < 2; ++n) { const size_t ix = ro + bj * HALF + n * 16; const f32x4 x = *(const f32x4*)(X + ix); *(f32x4*)(Y + ix) = x + acc[ai][bj][m][n]; } }
    }
};

template <class Epi, class Sched, bool ALIGN_EPI = false, bool SP2 = false>
__device__ __forceinline__ void gemm_phase(PG8_LAS unsigned char* lds, const Gemm g, const Sched& S, const Epi& E) {
    int tid = threadIdx.x; asm volatile("" : "+v"(tid));
    const int wid = __builtin_amdgcn_readfirstlane(tid >> 6), lane = tid & 63, wr = wid >> 2, wc = wid & 3, fr = lane & 15, fq = lane >> 4;
    const int K = g.K, nt = K / BK;
    unsigned voffA[2], voffB[2];
#pragma unroll
    for (int i = 0; i < 2; ++i) { int R, C; stage_rc(tid * 16 + i * 8192, R, C); const int Rb = Epi::PERM ? ((R & ~31) + perm32(R & 31)) : R;
        voffA[i] = (unsigned)(R * K + C) * 2u; voffB[i] = (unsigned)(Rb * K + C) * 2u; }
    const size_t kstep = (size_t)(BK * 2);
    const size_t hstep = (size_t)HALF * K * 2;
    const size_t tstep = 2 * hstep;
    const unsigned ldsw = (unsigned)wid * 1024u;
    const int aoff = lds_byte(wr * 64 + fr, fq * 8), boff = lds_byte(wc * 32 + fr, fq * 8);
#define PG8_SA(b, h) (((b) * 2 + (h)) * HTB)
#define PG8_SB(b, h) ((4 + (b) * 2 + (h)) * HTB)
#define PG8_STAGE(bufoff, gbase, voff) do { _Pragma("unroll") for (int _i = 0; _i < 2; ++_i) \
        __builtin_amdgcn_global_load_lds((const unsigned*)((const char*)(gbase) + (voff)[_i]), (PG8_LAS unsigned*)(lds + (bufoff) + ldsw + _i * 8192), 16, 0, 0); } while (0)
#define PG8_LDA(dst, b, h) do { _Pragma("unroll") for (int m = 0; m < 4; ++m) _Pragma("unroll") for (int k = 0; k < 2; ++k) dst[m][k] = *(const PG8_LAS bf16x8*)(lds + PG8_SA(b, h) + aoff + m * 2048 + k * 1024); } while (0)
#define PG8_LDB(dst, b, h) do { _Pragma("unroll") for (int n = 0; n < 2; ++n) _Pragma("unroll") for (int k = 0; k < 2; ++k) dst[n][k] = *(const PG8_LAS bf16x8*)(lds + PG8_SB(b, h) + boff + n * 2048 + k * 1024); } while (0)
#define PG8_MMA(ai, bj, At, Bt) do { __builtin_amdgcn_s_setprio(1); _Pragma("unroll") for (int m = 0; m < 4; ++m) _Pragma("unroll") for (int n = 0; n < 2; ++n) _Pragma("unroll") for (int k = 0; k < 2; ++k) \
        acc[ai][bj][m][n] = __builtin_amdgcn_mfma_f32_16x16x32_bf16(Bt[n][k], At[m][k], acc[ai][bj][m][n], 0, 0, 0); __builtin_amdgcn_s_setprio(0); } while (0)
#define PG8_WAIT_V(n) asm volatile("s_waitcnt vmcnt(" #n ")" ::: "memory")
#define PG8_WAIT_L(n) asm volatile("s_waitcnt lgkmcnt(" #n ")" ::: "memory")
#define PG8_BAR __builtin_amdgcn_s_barrier()
#define PG8_SCHED __builtin_amdgcn_sched_barrier(0)
    Unit cur, nxt; int ui = 0;
    if (!S.next(0, cur)) return;
    f32x4 acc[2][2][4][2];
#pragma unroll
    for (int a = 0; a < 2; ++a)
#pragma unroll
        for (int b = 0; b < 2; ++b)
#pragma unroll
            for (int m = 0; m < 4; ++m)
#pragma unroll
                for (int n = 0; n < 2; ++n) acc[a][b][m][n] = (f32x4){0.f, 0.f, 0.f, 0.f};
    bf16x8 At[4][2], B0[2][2], B1[2][2];
    const char* cA = (const char*)g.A + (size_t)cur.pm * tstep; const char* cB = (const char*)g.Bt + (size_t)cur.pn * tstep;
    S.a_ready(cur);
    if constexpr (SP2) {
        PG8_STAGE(PG8_SB(0, 0), cB, voffB); PG8_STAGE(PG8_SB(0, 1), cB + hstep, voffB); PG8_STAGE(PG8_SA(0, 0), cA, voffA); PG8_STAGE(PG8_SA(0, 1), cA + hstep, voffA);
        if (wr == 1) PG8_BAR;
        PG8_WAIT_V(2); PG8_BAR;
        PG8_STAGE(PG8_SB(1, 0), cB + kstep, voffB); PG8_STAGE(PG8_SA(1, 0), cA + kstep, voffA); PG8_STAGE(PG8_SB(1, 1), cB + hstep + kstep, voffB);
        PG8_WAIT_V(6); PG8_BAR;
    } else {
        PG8_STAGE(PG8_SB(0, 0), cB, voffB); PG8_STAGE(PG8_SA(0, 0), cA, voffA); PG8_STAGE(PG8_SB(0, 1), cB + hstep, voffB); PG8_STAGE(PG8_SA(0, 1), cA + hstep, voffA);
        if (wr == 1) PG8_BAR;
        PG8_WAIT_V(4); PG8_BAR;
        PG8_STAGE(PG8_SB(1, 0), cB + kstep, voffB); PG8_STAGE(PG8_SA(1, 0), cA + kstep, voffA); PG8_STAGE(PG8_SB(1, 1), cB + hstep + kstep, voffB);
        PG8_WAIT_V(6); PG8_BAR;
    }
    for (;;) {
        const bool has_next = S.next(ui + 1, nxt);
        const char* nA = has_next ? (const char*)g.A + (size_t)nxt.pm * tstep : cA; const char* nB = has_next ? (const char*)g.Bt + (size_t)nxt.pn * tstep : cB;
        for (int t = 0; t < nt; t += 2) {
            const bool last = (t == nt - 2);
            const char* a1 = cA + (size_t)(t + 1) * kstep;
            const char* a2 = last ? nA : cA + (size_t)(t + 2) * kstep; const char* b2 = last ? nB : cB + (size_t)(t + 2) * kstep;
            const char* a3 = a2 + kstep; const char* b3 = b2 + kstep;
            if (last && has_next) S.a_ready(nxt);
            if constexpr (SP2) {
            PG8_LDB(B0, 0, 0); PG8_LDB(B1, 0, 1); PG8_SCHED; PG8_LDA(At, 0, 0); PG8_STAGE(PG8_SA(1, 1), a1 + hstep, voffA);
            PG8_WAIT_V(8); PG8_WAIT_L(0); PG8_BAR; PG8_MMA(0, 0, At, B0); PG8_MMA(0, 1, At, B1); PG8_BAR; PG8_SCHED;
            PG8_LDA(At, 0, 1); PG8_STAGE(PG8_SB(0, 0), b2, voffB); PG8_STAGE(PG8_SB(0, 1), b2 + hstep, voffB); PG8_STAGE(PG8_SA(0, 0), a2, voffA);
            PG8_WAIT_V(8); PG8_WAIT_L(0); PG8_BAR; PG8_MMA(1, 0, At, B0); PG8_MMA(1, 1, At, B1); PG8_BAR; PG8_SCHED;
            PG8_LDB(B0, 1, 0); PG8_LDB(B1, 1, 1); PG8_SCHED; PG8_LDA(At, 1, 0); PG8_STAGE(PG8_SA(0, 1), a2 + hstep, voffA);
            PG8_WAIT_V(8); PG8_WAIT_L(0); PG8_BAR; PG8_MMA(0, 0, At, B0); PG8_MMA(0, 1, At, B1); PG8_BAR; PG8_SCHED;
            PG8_LDA(At, 1, 1); PG8_STAGE(PG8_SB(1, 0), b3, voffB); PG8_STAGE(PG8_SB(1, 1), b3 + hstep, voffB); PG8_STAGE(PG8_SA(1, 0), a3, voffA);
            PG8_WAIT_V(8); PG8_WAIT_L(0); PG8_BAR; PG8_MMA(1, 0, At, B0); PG8_MMA(1, 1, At, B1); PG8_BAR; PG8_SCHED;
            } else {
            PG8_LDB(B0, 0, 0); PG8_SCHED; PG8_LDA(At, 0, 0); PG8_STAGE(PG8_SA(1, 1), a1 + hstep, voffA);
            PG8_WAIT_L(8); PG8_BAR; PG8_WAIT_L(0); PG8_MMA(0, 0, At, B0); PG8_BAR; PG8_SCHED;
            PG8_LDB(B1, 0, 1); PG8_STAGE(PG8_SB(0, 0), b2, voffB);
            PG8_BAR; PG8_WAIT_L(0); PG8_MMA(0, 1, At, B1); PG8_BAR;
            PG8_LDA(At, 0, 1); PG8_STAGE(PG8_SA(0, 0), a2, voffA);
            PG8_BAR; PG8_WAIT_L(0); PG8_MMA(1, 0, At, B0); PG8_BAR; PG8_SCHED;
            PG8_STAGE(PG8_SB(0, 1), b2 + hstep, voffB);
            PG8_WAIT_V(6); PG8_BAR; PG8_MMA(1, 1, At, B1); PG8_BAR;
            PG8_LDB(B0, 1, 0); PG8_SCHED; PG8_LDA(At, 1, 0); PG8_STAGE(PG8_SA(0, 1), a2 + hstep, voffA);
            PG8_WAIT_L(8); PG8_BAR; PG8_WAIT_L(0); PG8_MMA(0, 0, At, B0); PG8_BAR; PG8_SCHED;
            PG8_LDB(B1, 1, 1); PG8_STAGE(PG8_SB(1, 0), b3, voffB);
            PG8_BAR; PG8_WAIT_L(0); PG8_MMA(0, 1, At, B1); PG8_BAR;
            PG8_LDA(At, 1, 1); PG8_STAGE(PG8_SA(1, 0), a3, voffA);
            PG8_BAR; PG8_WAIT_L(0); PG8_MMA(1, 0, At, B0); PG8_BAR; PG8_SCHED;
            PG8_STAGE(PG8_SB(1, 1), b3 + hstep, voffB);
            PG8_WAIT_V(6); PG8_BAR; PG8_MMA(1, 1, At, B1); PG8_BAR;
            }
        }
        if constexpr (ALIGN_EPI) { if (wr == 0) PG8_BAR; }
        E(acc, cur, wr, wc, fr, fq); S.done(cur);
        if (!has_next) break;
#pragma unroll
        for (int a = 0; a < 2; ++a)
#pragma unroll
            for (int b = 0; b < 2; ++b)
#pragma unroll
                for (int m = 0; m < 4; ++m)
#pragma unroll
                    for (int n = 0; n < 2; ++n) acc[a][b][m][n] = (f32x4){0.f, 0.f, 0.f, 0.f};
        cur = nxt; cA = nA; cB = nB; ++ui;
        if constexpr (ALIGN_EPI) { if (wr == 1) PG8_BAR; }
    }
    PG8_WAIT_V(0);
    if constexpr (!ALIGN_EPI) { if (wr == 0) PG8_BAR; }
    PG8_BAR;
#undef PG8_SA
#undef PG8_SB
#undef PG8_STAGE
#undef PG8_LDA
#undef PG8_LDB
#undef PG8_MMA
#undef PG8_WAIT_V
#undef PG8_WAIT_L
#undef PG8_BAR
#undef PG8_SCHED
}
}

#define XB_TMO      128
#define XB_XCNT(j)  (256  + 64 * (j))
#define XB_XSUB(j)  (1280 + 64 * (j))
#define XB_XGEN(j)  (2304 + 64 * (j))
#define XB_TOP      3328
#define XB_TOPGEN   3392
#define XCD_BAR_WORDS 3456
#define XB_SPIN_CAP (1u << 18)

__device__ __forceinline__ unsigned xb_ld(unsigned* p)              { return __hip_atomic_load(p, __ATOMIC_RELAXED, __HIP_MEMORY_SCOPE_AGENT); }
__device__ __forceinline__ unsigned xb_add(unsigned* p, unsigned v) { return __hip_atomic_fetch_add(p, v, __ATOMIC_RELAXED, __HIP_MEMORY_SCOPE_AGENT); }
__device__ __forceinline__ unsigned xb_xcc_id() { return (unsigned)__builtin_amdgcn_s_getreg((3 << 11) | 20) & 0xFu; }
#define XB_SPIN(cond, bar) do { unsigned _sp = 0; while (cond) { __builtin_amdgcn_s_sleep(1); \
    if ((++_sp & 255u) == 0u) { if (xb_ld(&(bar)[XB_TMO])) break; if (_sp > XB_SPIN_CAP) { atomicAdd(&(bar)[XB_TMO], 1u); break; } } } } while (0)

struct XcdBarrier {
    unsigned* bar; unsigned x;
    volatile LAS unsigned* st;
};

__device__ __forceinline__ XcdBarrier xcd_barrier_post(unsigned* bar, volatile LAS unsigned* st) {
    XcdBarrier b; b.bar = bar; b.x = xb_xcc_id(); b.st = st;
    if (threadIdx.x == 0) (void)xb_add(&bar[XB_XCNT(b.x)], 1u);
    return b;
}
__device__ __forceinline__ void xcd_barrier_complete(unsigned* bar, unsigned x, unsigned& nloc, unsigned& nx) {
    const unsigned G = gridDim.x * gridDim.y * gridDim.z;
    unsigned sum, cnt, mine, sp = 0u;
    for (;;) {
        sum = 0u; cnt = 0u; mine = 0u;
#pragma unroll
        for (unsigned j = 0; j < 16; ++j) { const unsigned c = xb_ld(&bar[XB_XCNT(j)]); sum += c; cnt += (c > 0u) ? 1u : 0u; mine = (j == x) ? c : mine; }
        if (sum == G) break;
        __builtin_amdgcn_s_sleep(1);
        if ((++sp & 255u) == 0u) { if (xb_ld(&bar[XB_TMO])) break; if (sp > XB_SPIN_CAP) { atomicAdd(&bar[XB_TMO], 1u); break; } }
    }
    nloc = mine > 0u ? mine : 1u; nx = cnt > 0u ? cnt : 1u;
}

__device__ __forceinline__ void xcd_barrier(const XcdBarrier& b) {
    asm volatile("s_waitcnt vmcnt(0)" ::: "memory");
    __syncthreads();
    if (threadIdx.x == 0) {
        unsigned* bar = b.bar;
        __builtin_amdgcn_s_waitcnt(0);
        unsigned nloc = b.st[0], nx = b.st[1];
        if (nloc == 0u) { xcd_barrier_complete(bar, b.x, nloc, nx); b.st[0] = nloc; b.st[1] = nx; }
        const unsigned old = xb_add(&bar[XB_XSUB(b.x)], 1u);
        const unsigned gen = old / nloc;
        if (old + 1u == (gen + 1u) * nloc) {
            __builtin_amdgcn_fence(__ATOMIC_RELEASE, "agent");
            asm volatile("s_waitcnt vmcnt(0)" ::: "memory");
            const unsigned og = xb_add(&bar[XB_TOP], 1u);
            const unsigned tg = og / nx;
            if (og + 1u == (tg + 1u) * nx) xb_add(&bar[XB_TOPGEN], 1u);
            else XB_SPIN(xb_ld(&bar[XB_TOPGEN]) == tg, bar);
            __builtin_amdgcn_fence(__ATOMIC_ACQUIRE, "agent");
            xb_add(&bar[XB_XGEN(b.x)], 1u);
            asm volatile("s_waitcnt vmcnt(0)" ::: "memory");
        } else {
            XB_SPIN(xb_ld(&bar[XB_XGEN(b.x)]) == gen, bar);
            __builtin_amdgcn_fence(__ATOMIC_ACQUIRE, "agent");
            asm volatile("s_waitcnt vmcnt(0)" ::: "memory");
        }
    }
    __syncthreads();
}

struct Args { const float* in[15]; float* out; unsigned char* ws; };

#define TIDS int tid = threadIdx.x; asm volatile("" : "+v"(tid)); const int lane = tid & 63, wave = __builtin_amdgcn_readfirstlane(tid >> 6); (void)lane; (void)wave
struct Ctx {
    LAS unsigned char* lds;
    int G, bid, vcu;
    const float* in[15]; float* out; unsigned char* ws;
};

constexpr int W_FIRST = 16 * 192 + 32 * 32, W_ALL = 2 * (16 * 192 + 32 * 32 + 16 * 72 + 16 * 32);
__device__ __forceinline__ void transpose_item(const float* W, int K, int N, bf16_t* WT, LAS float* scr, int item, int lane) {
    const int nblk = N / 32, kb = item / nblk, nb = item % nblk, k0 = 64 * kb, n0 = 32 * nb;
#pragma unroll 8
    for (int i = 0; i < 32; ++i) { const int kk = 2 * i + (lane >> 5); scr[kk * 33 + (lane & 31)] = W[(size_t)(k0 + kk) * N + n0 + (lane & 31)]; }
    asm volatile("s_waitcnt lgkmcnt(0)" ::: "memory");
    const int c = lane & 7;
#pragma unroll
    for (int j = 0; j < 4; ++j) { const int n = (lane >> 3) + 8 * j; const LAS float* s = scr + (8 * c) * 33 + n;
        u32x4 o; o.x = cvt_pk_bf16(s[0 * 33], s[1 * 33]); o.y = cvt_pk_bf16(s[2 * 33], s[3 * 33]); o.z = cvt_pk_bf16(s[4 * 33], s[5 * 33]); o.w = cvt_pk_bf16(s[6 * 33], s[7 * 33]);
        *(u32x4*)(WT + (size_t)(n0 + n) * K + k0 + 8 * c) = o; }
    asm volatile("s_waitcnt lgkmcnt(0)" ::: "memory");
}
__device__ __forceinline__ void phase_weights(Ctx& F, int lo, int hi, int gwb, int NGW) {
    TIDS;
    LAS float* scr = (LAS float*)(F.lds + wave * 16384);
    const int gw = gwb + wave;
    constexpr int I_RI = 16 * 192, I_RO = 32 * 32, I_SI = 16 * 72, I_SO = 16 * 32, PER = I_RI + I_RO + I_SI + I_SO;
    for (int it = lo + gw; it < hi; it += NGW) {
        const int li = it / PER; int r = it % PER;
        if (r < I_RI) { transpose_item(F.in[6] + (size_t)li * D * RET_IN, D, RET_IN, (bf16_t*)(F.ws + WS_WIN_RET) + (size_t)li * RET_IN * D, scr, r, lane); continue; } r -= I_RI;
        if (r < I_RO) { transpose_item(F.in[8] + (size_t)li * RET_V * D, RET_V, D, (bf16_t*)(F.ws + WS_WOUT_RET) + (size_t)li * D * RET_V, scr, r, lane); continue; } r -= I_RO;
        if (r < I_SI) { transpose_item(F.in[10] + (size_t)li * D * SWA_IN, D, SWA_IN, (bf16_t*)(F.ws + WS_WIN_SWA) + (size_t)li * SWA_IN * D, scr, r, lane); continue; } r -= I_SI;
        transpose_item(F.in[14] + (size_t)li * D * D, D, D, (bf16_t*)(F.ws + WS_WOUT_SWA) + (size_t)li * D * D, scr, r, lane);
    }
}
__device__ __forceinline__ void phase_norm(Ctx& F, const float* xp, const float* xs, const float* g) {
    TIDS;
    bf16_t* H = (bf16_t*)(F.ws + WS_H);
    const int gw = F.bid * 8 + wave, NGW = F.G * 8;
    f32x4 gv[4];
#pragma unroll
    for (int j = 0; j < 4; ++j) gv[j] = *((const f32x4*)g + lane + 64 * j);
    for (int r0 = gw; r0 < MP + MS; r0 += 2 * NGW) {
        const int r1 = r0 + NGW; const bool has1 = r1 < MP + MS; const int r1c = has1 ? r1 : r0;
        const float* s0 = r0 < MP ? xp + (size_t)r0 * D : xs + (size_t)(r0 - MP) * D;
        const float* s1 = r1c < MP ? xp + (size_t)r1c * D : xs + (size_t)(r1c - MP) * D;
        f32x4 v[4], u[4]; float a = 0.f, b = 0.f;
#pragma unroll
        for (int j = 0; j < 4; ++j) { v[j] = ((const f32x4*)s0 + lane)[64 * j]; u[j] = ((const f32x4*)s1 + lane)[64 * j]; }
#pragma unroll
        for (int j = 0; j < 4; ++j) { a += (v[j].x * v[j].x + v[j].y * v[j].y) + (v[j].z * v[j].z + v[j].w * v[j].w); b += (u[j].x * u[j].x + u[j].y * u[j].y) + (u[j].z * u[j].z + u[j].w * u[j].w); }
#pragma unroll
        for (int o = 1; o < 64; o <<= 1) { a += __shfl_xor(a, o); b += __shfl_xor(b, o); }
        const float ra = rsqrtf(a * (1.f / D) + EPS), rb = rsqrtf(b * (1.f / D) + EPS);
        u32x2* o0 = (u32x2*)(H + (size_t)r0 * D) + lane; u32x2* o1 = (u32x2*)(H + (size_t)r1c * D) + lane;
#pragma unroll
        for (int j = 0; j < 4; ++j) { f32x4 y = v[j] * ra * gv[j]; u32x2 w; w.x = cvt_pk_bf16(y.x, y.y); w.y = cvt_pk_bf16(y.z, y.w); o0[64 * j] = w; }
        if (has1) {
#pragma unroll
            for (int j = 0; j < 4; ++j) { f32x4 y = u[j] * rb * gv[j]; u32x2 w; w.x = cvt_pk_bf16(y.x, y.y); w.y = cvt_pk_bf16(y.z, y.w); o1[64 * j] = w; }
        }
    }
}

template <int K, int RM, class EF>
__device__ __forceinline__ void small_gemm(Ctx& F, const bf16_t* A, const bf16_t* Bt, int N, EF epi) {
    TIDS;
    constexpr int KW = K / 8, PST = 68, ROWS = 16 * RM, RB = 128 / ROWS;
    const int fr = lane & 15, fq = lane >> 4, nU = (N / 64) * RB;
    LAS float* part = (LAS float*)F.lds;
    for (int u = F.G - 1 - F.bid; u < nU; u += F.G) {
        const int n0 = (u / RB) * 64, r0 = (u % RB) * ROWS;
        const bf16x8* ap = (const bf16x8*)(A + (size_t)(r0 + fr) * K + wave * KW + 8 * fq);
        const bf16x8* bp = (const bf16x8*)(Bt + (size_t)(n0 + fr) * K + wave * KW + 8 * fq);
        f32x4 acc[RM][4];
#pragma unroll
        for (int m = 0; m < RM; ++m)
#pragma unroll
            for (int n = 0; n < 4; ++n) acc[m][n] = (f32x4){0.f, 0.f, 0.f, 0.f};
#pragma unroll 2
        for (int k = 0; k < KW / 32; ++k) {
            bf16x8 a[RM], bb[4];
#pragma unroll
            for (int m = 0; m < RM; ++m) a[m] = ap[(size_t)m * 16 * K / 8 + 4 * k];
#pragma unroll
            for (int n = 0; n < 4; ++n) bb[n] = bp[(size_t)n * 16 * K / 8 + 4 * k];
#pragma unroll
            for (int m = 0; m < RM; ++m)
#pragma unroll
                for (int n = 0; n < 4; ++n) acc[m][n] = MFMA16(bb[n], a[m], acc[m][n]);
        }
        __syncthreads();
#pragma unroll
        for (int m = 0; m < RM; ++m)
#pragma unroll
            for (int n = 0; n < 4; ++n) *(LAS f32x4*)(part + (wave * ROWS + 16 * m + fr) * PST + 16 * n + 4 * fq) = acc[m][n];
        __syncthreads();
#pragma unroll
        for (int q = 0; q < (ROWS * 16) / 512; ++q) {
            const int g = q * 512 + tid, row = g >> 4, c4 = (g & 15) * 4;
            f32x4 sm = {0.f, 0.f, 0.f, 0.f};
#pragma unroll
            for (int w8 = 0; w8 < 8; ++w8) sm += *(LAS f32x4*)(part + (w8 * ROWS + row) * PST + c4);
            epi(r0 + row, n0 + c4, sm);
        }
    }
}

constexpr int PK_STRIDE = 528;
__device__ __forceinline__ void ret_P_item(Ctx& F, int item) {
    TIDS;
    const bf16_t* PROJ = (const bf16_t*)(F.ws + WS_PROJ); bf16_t* P = (bf16_t*)(F.ws + WS_P) + (size_t)item * 16384;
    const int b = item >> 7, h = (item >> 5) & 3, c = item & 31, fr = lane & 15, fq = lane >> 4, w = wave;
    const int tile_ = (b * 32 + c) * 4 + h;
    const float l2g = log2f(1.f - exp2f(-5.f - (float)h));
    LAS unsigned char* KL = F.lds;
    u32x4 kreg[8]; bf16x8 qreg[8];
#pragma unroll
    for (int i = 0; i < 8; ++i) kreg[i] = *((const u32x4*)((const bf16_t*)(F.ws + WS_KB) + (size_t)tile_ * 32768) + i * 512 + tid);
    const bf16x8* qp = (const bf16x8*)((const bf16_t*)(F.ws + WS_QB) + (size_t)tile_ * 32768 + (16 * w + fr) * 256 + 8 * fq);
#pragma unroll
    for (int ks = 0; ks < 8; ++ks) qreg[ks] = qp[4 * ks];
    __syncthreads();
#pragma unroll
    for (int i = 0; i < 8; ++i) { const int cid = i * 512 + tid, s_ = cid >> 5, ch = cid & 31; *(LAS u32x4*)(KL + s_ * PK_STRIDE + 16 * ch) = kreg[i]; }
    __syncthreads();
    f32x4 acc[8];
#pragma unroll
    for (int n = 0; n < 8; ++n) acc[n] = (f32x4){0.f, 0.f, 0.f, 0.f};
#pragma unroll
    for (int ks = 0; ks < 8; ++ks) {
#pragma unroll
        for (int n = 0; n < 8; ++n) if (n <= w) { const bf16x8 k = *(const LAS bf16x8*)(KL + (16 * n + fr) * PK_STRIDE + (32 * ks + 8 * fq) * 2); acc[n] = MFMA16(k, qreg[ks], acc[n]); }
    }
    const int t = 16 * w + fr;
#pragma unroll
    for (int n = 0; n < 8; ++n) {
        float v[4];
#pragma unroll
        for (int r = 0; r < 4; ++r) { const int s_ = 16 * n + 4 * fq + r; v[r] = (t >= s_) ? acc[n][r] * exp2f(l2g * (float)(t - s_)) : 0.f; }
        u32x2 o; o.x = cvt_pk_bf16(v[0], v[1]); o.y = cvt_pk_bf16(v[2], v[3]);
        *(u32x2*)(P + t * 128 + 16 * n + 4 * fq) = o;
    }
}
__device__ __forceinline__ void ret_sample_item(Ctx& F, int li, int item) {
    TIDS;
    const bf16_t* PROJ = (const bf16_t*)(F.ws + WS_PROJ); bf16_t* O = (bf16_t*)(F.ws + WS_O);
    const int b = item >> 2, h = item & 3;
    LAS float* qk = (LAS float*)F.lds;
    LAS float* red = (LAS float*)F.lds + 512;
    const bf16_t* row = PROJ + (size_t)(MP + b) * RET_IN;
    __syncthreads();
    qk[tid] = bf2f(row[(tid < 256 ? 0 : 1024 - 256) + h * 256 + tid]);
    __syncthreads();
    const int eq = tid & 127, dg = tid >> 7;
    const float gam = 1.f - exp2f(-5.f - (float)h);
    const u32x2 vraw = *(const u32x2*)(row + 2048 + h * 512 + 4 * eq);
    const f32x4 v4 = {bf_lo(vraw.x), bf_hi(vraw.x), bf_lo(vraw.y), bf_hi(vraw.y)};
    const size_t sbase = ((size_t)(li * 128 + b) * 4 + h) * 131072;
    const f32x4* Sin = (const f32x4*)(F.in[2] + sbase) + eq; f32x4* Sout = (f32x4*)(F.out + O_RETS + sbase) + eq;
    f32x4 o4 = {0.f, 0.f, 0.f, 0.f};
    {
        f32x4 buf[16];
        const f32x4* Sr = Sin + (size_t)dg * 64 * 128; f32x4* Sw = Sout + (size_t)dg * 64 * 128;
#pragma unroll
        for (int i = 0; i < 16; ++i) buf[i] = __builtin_nontemporal_load(Sr + i * 128);
#pragma unroll
        for (int i = 0; i < 64; ++i) {
            const int d = dg * 64 + i;
            const f32x4 sn = buf[i & 15] * gam + v4 * qk[256 + d];
            if (i + 16 < 64) buf[i & 15] = __builtin_nontemporal_load(Sr + (i + 16) * 128);
            __builtin_nontemporal_store(sn, Sw + i * 128);
            o4 += sn * qk[d];
        }
    }
    *(LAS f32x4*)(red + dg * 512 + 4 * eq) = o4;
    __syncthreads();
    if (tid < 128) {
        f32x4 s = *(LAS f32x4*)(red + 4 * tid) + *(LAS f32x4*)(red + 512 + 4 * tid) + *(LAS f32x4*)(red + 1024 + 4 * tid) + *(LAS f32x4*)(red + 1536 + 4 * tid);
        u32x2 o; o.x = cvt_pk_bf16(s.x, s.y); o.y = cvt_pk_bf16(s.z, s.w);
        *(u32x2*)(O + (size_t)(MP + b) * RET_V + h * 512 + 4 * tid) = o;
    }
}
constexpr int KL_STRIDE = 544, KL_OFF = 0, VL_STRIDE = 144, VL_OFF = 69632, VDL_OFF = 88064, STL_OFF = 106496, STL_STRIDE = 528;
__device__ __forceinline__ void ret_scan_item(Ctx& F, int li, int item) {
    TIDS;
    bf16_t* O = (bf16_t*)(F.ws + WS_O);
    const int b = item >> 5, h = (item >> 3) & 3, es = item & 7, e0 = es * 64;
    const int fr = lane & 15, fq = lane >> 4, q4 = fr >> 2, p4 = fr & 3;
    const float l2g = log2f(1.f - exp2f(-5.f - (float)h));
    LAS unsigned char* KL = F.lds + KL_OFF; LAS unsigned char* VL = F.lds + VL_OFF; LAS unsigned char* VDL = F.lds + VDL_OFF; LAS unsigned char* STL = F.lds + STL_OFF;
    const size_t tokb = (size_t)b * SEQ;
    const bf16_t* QBp = (const bf16_t*)(F.ws + WS_QB); const bf16_t* KBp = (const bf16_t*)(F.ws + WS_KB); const bf16_t* VBp = (const bf16_t*)(F.ws + WS_VB);
    const int tileb = (b * 32) * 4 + h;
    __syncthreads();
    for (int i = tid; i < 64 * STL_STRIDE / 4; i += 512) ((LAS unsigned*)STL)[i] = 0u;
    if (wave < 4) {
        const int t0 = 16 * wave + fr, t1 = 16 * (7 - wave) + fr, dT = t1 - t0;
        const float cross0 = exp2f(l2g * (float)(t0 + 1)), cross1 = exp2f(l2g * (float)(t1 + 1));
        const bf16_t* Qb = QBp + (size_t)tileb * 32768 + t0 * 256 + 8 * fq;
        bf16x8 qreg[2][8];
#pragma unroll
        for (int tt = 0; tt < 2; ++tt) {
#pragma unroll
            for (int ks = 0; ks < 8; ++ks) qreg[tt][ks] = *(const bf16x8*)(Qb + tt * dT * 256 + 32 * ks);
        }
        const float gt0 = exp2f(l2g * (float)t0), gt1 = exp2f(l2g * (float)t1);
        float gsr[4], gn[8];
#pragma unroll
        for (int r = 0; r < 4; ++r) gsr[r] = exp2f(-l2g * (float)(4 * fq + r));
#pragma unroll
        for (int n = 0; n < 8; ++n) gn[n] = exp2f(-l2g * (float)(16 * n));
        const int nmax0 = wave, nmax1 = 7 - wave;
#pragma unroll 1
        for (int c = 0; c < 32; ++c) {
            LDS_BARRIER();
            f32x4 aS[2][4];
#pragma unroll
            for (int tt = 0; tt < 2; ++tt)
#pragma unroll
                for (int e = 0; e < 4; ++e) aS[tt][e] = (f32x4){0.f, 0.f, 0.f, 0.f};
#pragma unroll
            for (int ks = 0; ks < 8; ++ks) {
#pragma unroll
                for (int e = 0; e < 4; ++e) {
                    const bf16x8 sf = *(const LAS bf16x8*)(STL + (16 * e + fr) * STL_STRIDE + (32 * ks + 8 * fq) * 2);
                    aS[0][e] = MFMA16(sf, qreg[0][ks], aS[0][e]); aS[1][e] = MFMA16(sf, qreg[1][ks], aS[1][e]);
                }
            }
            bf16x8 pf[2][4];
            {
                f32x4 pa[2][8];
#pragma unroll
                for (int tt = 0; tt < 2; ++tt)
#pragma unroll
                    for (int n = 0; n < 8; ++n) pa[tt][n] = (f32x4){0.f, 0.f, 0.f, 0.f};
#pragma unroll
                for (int ks = 0; ks < 8; ++ks) {
#pragma unroll
                    for (int n = 0; n < 8; ++n) if (n <= nmax1) {
                        const bf16x8 kfr = *(const LAS bf16x8*)(KL + (16 * n + fr) * KL_STRIDE + (32 * ks + 8 * fq) * 2);
                        if (n <= nmax0) pa[0][n] = MFMA16(kfr, qreg[0][ks], pa[0][n]);
                        pa[1][n] = MFMA16(kfr, qreg[1][ks], pa[1][n]);
                    }
                }
                const int cn = c < 31 ? c + 1 : 31;
#pragma unroll
                for (int tt = 0; tt < 2; ++tt) {
#pragma unroll
                    for (int ks = 0; ks < 8; ++ks) qreg[tt][ks] = *(const bf16x8*)(Qb + (size_t)cn * 4 * 32768 + tt * dT * 256 + 32 * ks);
                }
                float gt0l = gt0, gt1l = gt1; int t0l = t0;
                asm volatile("" : "+v"(gt0l), "+v"(gt1l), "+v"(t0l));
#pragma unroll
                for (int tt = 0; tt < 2; ++tt) {
                    const int t = t0l + tt * dT; const float gt = tt ? gt1l : gt0l;
#pragma unroll
                    for (int n = 0; n < 8; ++n)
#pragma unroll
                        for (int r = 0; r < 4; ++r) { const int s_ = 16 * n + 4 * fq + r; pa[tt][n][r] = (t >= s_) ? pa[tt][n][r] * (gt * gn[n] * gsr[r]) : 0.f; }
#pragma unroll
                    for (int kk = 0; kk < 4; ++kk) pf[tt][kk] = pack8(pa[tt][2 * kk][0], pa[tt][2 * kk][1], pa[tt][2 * kk][2], pa[tt][2 * kk][3], pa[tt][2 * kk + 1][0], pa[tt][2 * kk + 1][1], pa[tt][2 * kk + 1][2], pa[tt][2 * kk + 1][3]);
                }
            }
            f32x4 aP[2][4];
#pragma unroll
            for (int tt = 0; tt < 2; ++tt)
#pragma unroll
                for (int e = 0; e < 4; ++e) aP[tt][e] = (f32x4){0.f, 0.f, 0.f, 0.f};
#pragma unroll
            for (int kk = 0; kk < 4; ++kk) if (2 * kk <= nmax1) {
#pragma unroll
                for (int e = 0; e < 4; ++e) {
                    const LAS unsigned char* a0 = VL + (32 * kk + 4 * fq + q4) * VL_STRIDE + (16 * e + 4 * p4) * 2;
                    const bf16x8 vf = cat8(tr_read(a0), tr_read(a0 + 16 * VL_STRIDE));
                    if (2 * kk <= nmax0) aP[0][e] = MFMA16(vf, pf[0][kk], aP[0][e]);
                    aP[1][e] = MFMA16(vf, pf[1][kk], aP[1][e]);
                }
            }
            const size_t tok0 = tokb + c * 128;
#pragma unroll
            for (int tt = 0; tt < 2; ++tt)
#pragma unroll
                for (int e = 0; e < 4; ++e) {
                    const f32x4 o = aP[tt][e] + aS[tt][e] * (tt ? cross1 : cross0);
                    u32x2 ow; ow.x = cvt_pk_bf16(o[0], o[1]); ow.y = cvt_pk_bf16(o[2], o[3]);
                    *(u32x2*)(O + (tok0 + t0 + tt * dT) * RET_V + h * 512 + e0 + 16 * e + 4 * fq) = ow;
                }
            LDS_BARRIER();
        }
    } else {
        const int gwv = wave - 4, gtid = tid - 256;
        const float cdec = exp2f(l2g * 128.f);
        f32x4 S[4][4];
#pragma unroll
        for (int a = 0; a < 4; ++a)
#pragma unroll
            for (int e = 0; e < 4; ++e) S[a][e] = (f32x4){0.f, 0.f, 0.f, 0.f};
        u32x4 kreg[16], vreg[4];
#pragma unroll
        for (int i = 0; i < 16; ++i) kreg[i] = *((const u32x4*)(KBp + (size_t)tileb * 32768) + i * 256 + gtid);
#pragma unroll
        for (int i = 0; i < 4; ++i) vreg[i] = *((const u32x4*)(VBp + ((size_t)tileb * 8 + es) * 8192) + i * 256 + gtid);
#pragma unroll 1
        for (int c = 0; c < 32; ++c) {
#pragma unroll
            for (int i = 0; i < 16; ++i) { const int cid = i * 256 + gtid, s_ = cid >> 5, ch = cid & 31; *(LAS u32x4*)(KL + s_ * KL_STRIDE + 16 * ch) = kreg[i]; }
#pragma unroll
            for (int i = 0; i < 4; ++i) { const int cid = i * 256 + gtid, s_ = cid >> 3, ch = cid & 7;
              *(LAS u32x4*)(VL + s_ * VL_STRIDE + 16 * ch) = vreg[i];
              const float dk = exp2f(l2g * (float)(127 - s_));
              u32x4 vd; vd.x = cvt_pk_bf16(bf_lo(vreg[i].x) * dk, bf_hi(vreg[i].x) * dk); vd.y = cvt_pk_bf16(bf_lo(vreg[i].y) * dk, bf_hi(vreg[i].y) * dk);
              vd.z = cvt_pk_bf16(bf_lo(vreg[i].z) * dk, bf_hi(vreg[i].z) * dk); vd.w = cvt_pk_bf16(bf_lo(vreg[i].w) * dk, bf_hi(vreg[i].w) * dk);
              *(LAS u32x4*)(VDL + s_ * VL_STRIDE + 16 * ch) = vd; }
            LDS_BARRIER();
            const int cn = c < 31 ? c + 1 : 31;
#pragma unroll
            for (int i = 0; i < 16; ++i) kreg[i] = *((const u32x4*)(KBp + (size_t)(tileb + 4 * cn) * 32768) + i * 256 + gtid);
#pragma unroll
            for (int i = 0; i < 4; ++i) vreg[i] = *((const u32x4*)(VBp + ((size_t)(tileb + 4 * cn) * 8 + es) * 8192) + i * 256 + gtid);
#pragma unroll
            for (int a = 0; a < 4; ++a)
#pragma unroll
                for (int e = 0; e < 4; ++e) S[a][e] *= cdec;
#pragma unroll
            for (int ks = 0; ks < 4; ++ks) {
                bf16x8 kf[4], vf[4];
#pragma unroll
                for (int a = 0; a < 4; ++a) { const LAS unsigned char* a0 = KL + (32 * ks + 8 * fq + q4) * KL_STRIDE + (64 * gwv + 16 * a + 4 * p4) * 2; kf[a] = cat8(tr_read(a0), tr_read(a0 + 4 * KL_STRIDE)); }
#pragma unroll
                for (int e = 0; e < 4; ++e) { const LAS unsigned char* a0 = VDL + (32 * ks + 8 * fq + q4) * VL_STRIDE + (16 * e + 4 * p4) * 2; vf[e] = cat8(tr_read(a0), tr_read(a0 + 4 * VL_STRIDE)); }
#pragma unroll
                for (int a = 0; a < 4; ++a)
#pragma unroll
                    for (int e = 0; e < 4; ++e) S[a][e] = MFMA16(kf[a], vf[e], S[a][e]);
            }
            LDS_BARRIER();
#pragma unroll
            for (int a = 0; a < 4; ++a)
#pragma unroll
                for (int e = 0; e < 4; ++e) { u32x2 sw; sw.x = cvt_pk_bf16(S[a][e][0], S[a][e][1]); sw.y = cvt_pk_bf16(S[a][e][2], S[a][e][3]);
                    *(LAS u32x2*)(STL + (16 * e + fr) * STL_STRIDE + (64 * gwv + 16 * a + 4 * fq) * 2) = sw; }
        }
        float* So = F.out + O_RETP + ((size_t)(li * 4 + b) * 4 + h) * 131072;
#pragma unroll
        for (int a = 0; a < 4; ++a)
#pragma unroll
            for (int e = 0; e < 4; ++e)
#pragma unroll
                for (int r = 0; r < 4; ++r) So[(size_t)(64 * gwv + 16 * a + 4 * fq + r) * 512 + e0 + 16 * e + fr] = S[a][e][r];
    }
}
__device__ __forceinline__ void phase_ret_gate(Ctx& F, int li) {
    TIDS;
    const bf16_t* PROJ = (const bf16_t*)(F.ws + WS_PROJ); const bf16_t* O = (const bf16_t*)(F.ws + WS_O); bf16_t* OG = (bf16_t*)(F.ws + WS_OG);
    const float* gn = F.in[7] + (size_t)li * RET_V;
    const int gw = F.bid * 8 + wave, NGW = F.G * 8;
    f32x4 gg[4][2];
#pragma unroll
    for (int h = 0; h < 4; ++h) { gg[h][0] = *(const f32x4*)(gn + h * 512 + 8 * lane); gg[h][1] = *(const f32x4*)(gn + h * 512 + 8 * lane + 4); }
    for (int row0 = gw; row0 < MP + MS; row0 += 2 * NGW) {
        const int row1 = row0 + NGW; const bool has1 = row1 < MP + MS;
        const int rows[2] = {row0, has1 ? row1 : row0};
        u32x4 ov[2][4], gv[2][4];
#pragma unroll
        for (int q = 0; q < 2; ++q)
#pragma unroll
            for (int h = 0; h < 4; ++h) { ov[q][h] = *(const u32x4*)(O + (size_t)rows[q] * RET_V + h * 512 + 8 * lane); gv[q][h] = *(const u32x4*)(PROJ + (size_t)rows[q] * RET_IN + 4096 + h * 512 + 8 * lane); }
        float ss[2][4];
#pragma unroll
        for (int q = 0; q < 2; ++q)
#pragma unroll
            for (int h = 0; h < 4; ++h) { const float a0 = bf_lo(ov[q][h].x), a1 = bf_hi(ov[q][h].x), a2 = bf_lo(ov[q][h].y), a3 = bf_hi(ov[q][h].y), a4 = bf_lo(ov[q][h].z), a5 = bf_hi(ov[q][h].z), a6 = bf_lo(ov[q][h].w), a7 = bf_hi(ov[q][h].w);
                ss[q][h] = (a0 * a0 + a1 * a1) + (a2 * a2 + a3 * a3) + (a4 * a4 + a5 * a5) + (a6 * a6 + a7 * a7); }
#pragma unroll
        for (int o = 1; o < 64; o <<= 1) {
#pragma unroll
            for (int q = 0; q < 2; ++q)
#pragma unroll
                for (int h = 0; h < 4; ++h) ss[q][h] += __shfl_xor(ss[q][h], o); }
#pragma unroll
        for (int q = 0; q < 2; ++q) {
            if (q == 1 && !has1) break;
#pragma unroll
            for (int h = 0; h < 4; ++h) {
                const float rstd = rsqrtf(ss[q][h] * (1.f / 512.f) + EPS);
                const f32x4 g0 = gg[h][0], g1 = gg[h][1];
                const u32x4 o4 = ov[q][h], t4 = gv[q][h];
                const float y0 = bf_lo(o4.x) * rstd * g0.x * silu(bf_lo(t4.x)), y1 = bf_hi(o4.x) * rstd * g0.y * silu(bf_hi(t4.x));
                const float y2 = bf_lo(o4.y) * rstd * g0.z * silu(bf_lo(t4.y)), y3 = bf_hi(o4.y) * rstd * g0.w * silu(bf_hi(t4.y));
                const float y4 = bf_lo(o4.z) * rstd * g1.x * silu(bf_lo(t4.z)), y5 = bf_hi(o4.z) * rstd * g1.y * silu(bf_hi(t4.z));
                const float y6 = bf_lo(o4.w) * rstd * g1.z * silu(bf_lo(t4.w)), y7 = bf_hi(o4.w) * rstd * g1.w * silu(bf_hi(t4.w));
                u32x4 w; w.x = cvt_pk_bf16(y0, y1); w.y = cvt_pk_bf16(y2, y3); w.z = cvt_pk_bf16(y4, y5); w.w = cvt_pk_bf16(y6, y7);
                *(u32x4*)(OG + (size_t)rows[q] * RET_V + h * 512 + 8 * lane) = w;
            }
        }
    }
}

constexpr int AK_STRIDE = 144, AK_OFF = 0, AV_OFF = 36864;
__device__ __forceinline__ void swa_prompt_item(Ctx& F, int li, int item) {
    TIDS;
    const bf16_t* PROJ = (const bf16_t*)(F.ws + WS_PROJ); bf16_t* OG = (bf16_t*)(F.ws + WS_OG);
    const int b = item >> 6, n = (item >> 1) & 31, kvh = item & 1;
    const int g = wave, fr = lane & 15, fq = lane >> 4, q4 = fr >> 2, p4 = fr & 3;
    LAS unsigned char* KL = F.lds + AK_OFF; LAS unsigned char* VL = F.lds + AV_OFF;
    const float* qg = F.in[11] + li * 64; const float* kg = F.in[12] + li * 64;
    __syncthreads();
    {
        const int u = tid >> 1, hf = tid & 1;
        u32x4 kw[4], vw[4];
        if (n == 0 && u < 128) {
#pragma unroll
            for (int i = 0; i < 4; ++i) { kw[i] = (u32x4){0u, 0u, 0u, 0u}; vw[i] = (u32x4){0u, 0u, 0u, 0u}; }
        } else {
            const size_t tok = (size_t)b * SEQ + (n - 1) * 128 + u;
            const u32x4* kp = (const u32x4*)(PROJ + tok * SWA_IN + 1024 + kvh * 64 + 32 * hf);
            const u32x4* vp = (const u32x4*)(PROJ + tok * SWA_IN + 1152 + kvh * 64 + 32 * hf);
            float kf[32]; float ss = 0.f;
#pragma unroll
            for (int i = 0; i < 4; ++i) { const u32x4 k = kp[i]; vw[i] = vp[i];
                kf[8 * i + 0] = bf_lo(k.x); kf[8 * i + 1] = bf_hi(k.x); kf[8 * i + 2] = bf_lo(k.y); kf[8 * i + 3] = bf_hi(k.y);
                kf[8 * i + 4] = bf_lo(k.z); kf[8 * i + 5] = bf_hi(k.z); kf[8 * i + 6] = bf_lo(k.w); kf[8 * i + 7] = bf_hi(k.w); }
#pragma unroll
            for (int i = 0; i < 32; ++i) ss += kf[i] * kf[i];
            ss += __shfl_xor(ss, 1);
            const float rstd = rsqrtf(ss * (1.f / 64.f) + EPS);
#pragma unroll
            for (int i = 0; i < 32; ++i) kf[i] = kf[i] * rstd * kg[32 * hf + i];
#pragma unroll
            for (int i = 0; i < 4; ++i) { kw[i].x = cvt_pk_bf16(kf[8 * i], kf[8 * i + 1]); kw[i].y = cvt_pk_bf16(kf[8 * i + 2], kf[8 * i + 3]); kw[i].z = cvt_pk_bf16(kf[8 * i + 4], kf[8 * i + 5]); kw[i].w = cvt_pk_bf16(kf[8 * i + 6], kf[8 * i + 7]); }
            if (n == 31 && u >= 128) {
                float* ko = F.out + O_KP + (((size_t)(li * 4 + b) * 128 + (u - 128)) * 2 + kvh) * 64 + 32 * hf;
                float* vo = F.out + O_VP + (((size_t)(li * 4 + b) * 128 + (u - 128)) * 2 + kvh) * 64 + 32 * hf;
#pragma unroll
                for (int i = 0; i < 8; ++i) *(f32x4*)(ko + 4 * i) = (f32x4){kf[4 * i], kf[4 * i + 1], kf[4 * i + 2], kf[4 * i + 3]};
#pragma unroll
                for (int i = 0; i < 4; ++i) { *(f32x4*)(vo + 8 * i) = (f32x4){bf_lo(vw[i].x), bf_hi(vw[i].x), bf_lo(vw[i].y), bf_hi(vw[i].y)}; *(f32x4*)(vo + 8 * i + 4) = (f32x4){bf_lo(vw[i].z), bf_hi(vw[i].z), bf_lo(vw[i].w), bf_hi(vw[i].w)}; }
            }
        }
#pragma unroll
        for (int i = 0; i < 4; ++i) { *(LAS u32x4*)(KL + u * AK_STRIDE + 64 * hf + 16 * i) = kw[i]; *(LAS u32x4*)(VL + u * AK_STRIDE + 64 * hf + 16 * i) = vw[i]; }
    }
    __syncthreads();
    const int head = kvh * 8 + g;
    const float slope2 = exp2f(-0.5f * (float)(head + 1)) * LOG2E;
    const float sink2 = F.in[13][li * 16 + head] * LOG2E;
    float qg0[8], qg1[8];
#pragma unroll
    for (int i = 0; i < 8; ++i) { qg0[i] = qg[8 * fq + i] * (0.125f * LOG2E); qg1[i] = qg[32 + 8 * fq + i] * (0.125f * LOG2E); }
    u32x4 nq0, nq1; u32x2 ngr[4];
    {   const size_t tokn = (size_t)b * SEQ + n * 128 + fr;
        nq0 = *(const u32x4*)(PROJ + tokn * SWA_IN + head * 64 + 8 * fq); nq1 = *(const u32x4*)(PROJ + tokn * SWA_IN + head * 64 + 32 + 8 * fq);
#pragma unroll
        for (int d = 0; d < 4; ++d) ngr[d] = *(const u32x2*)(PROJ + tokn * SWA_IN + 1280 + head * 64 + 16 * d + 4 * fq); }
#pragma unroll 1
    for (int tf = 0; tf < 8; ++tf) {
        const int j = 16 * tf + fr;
        const size_t tok = (size_t)b * SEQ + n * 128 + j;
        bf16x8 qf[2];
        const u32x4 r0 = nq0, r1 = nq1; u32x2 gcur[4];
#pragma unroll
        for (int d = 0; d < 4; ++d) gcur[d] = ngr[d];
        {   const size_t tokn = tok + (tf < 7 ? 16 : 0);
            nq0 = *(const u32x4*)(PROJ + tokn * SWA_IN + head * 64 + 8 * fq); nq1 = *(const u32x4*)(PROJ + tokn * SWA_IN + head * 64 + 32 + 8 * fq);
#pragma unroll
            for (int d = 0; d < 4; ++d) ngr[d] = *(const u32x2*)(PROJ + tokn * SWA_IN + 1280 + head * 64 + 16 * d + 4 * fq); }
        {
            float q0[8] = {bf_lo(r0.x), bf_hi(r0.x), bf_lo(r0.y), bf_hi(r0.y), bf_lo(r0.z), bf_hi(r0.z), bf_lo(r0.w), bf_hi(r0.w)};
            float q1[8] = {bf_lo(r1.x), bf_hi(r1.x), bf_lo(r1.y), bf_hi(r1.y), bf_lo(r1.z), bf_hi(r1.z), bf_lo(r1.w), bf_hi(r1.w)};
            float ss = 0.f;
#pragma unroll
            for (int i = 0; i < 8; ++i) ss += q0[i] * q0[i] + q1[i] * q1[i];
            ss += __shfl_xor(ss, 16); ss += __shfl_xor(ss, 32);
            const float sc = rsqrtf(ss * (1.f / 64.f) + EPS);
#pragma unroll
            for (int i = 0; i < 8; ++i) { q0[i] *= sc * qg0[i]; q1[i] *= sc * qg1[i]; }
            qf[0] = pack8(q0[0], q0[1], q0[2], q0[3], q0[4], q0[5], q0[6], q0[7]);
            qf[1] = pack8(q1[0], q1[1], q1[2], q1[3], q1[4], q1[5], q1[6], q1[7]);
        }
        const int f0 = tf < 6 ? tf : 6;
        f32x4 sc[10];
#pragma unroll
        for (int f = 0; f < 10; ++f) {
            sc[f] = (f32x4){0.f, 0.f, 0.f, 0.f};
#pragma unroll
            for (int ks = 0; ks < 2; ++ks) { const bf16x8 kf = *(const LAS bf16x8*)(KL + (16 * (f0 + f) + fr) * AK_STRIDE + (32 * ks + 8 * fq) * 2); sc[f] = MFMA16(kf, qf[ks], sc[f]); }
        }
        float mx = sink2;
#pragma unroll
        for (int f = 0; f < 10; ++f)
#pragma unroll
            for (int r = 0; r < 4; ++r) { const int u = 16 * (f0 + f) + 4 * fq + r; const int dist = 128 + j - u;
                const bool valid = (dist >= 0) && (dist <= 128) && (n > 0 || u >= 128);
                const float s = valid ? sc[f][r] - slope2 * (float)dist : -1e30f; sc[f][r] = s; mx = fmaxf(mx, s); }
        mx = fmaxf(mx, __shfl_xor(mx, 16)); mx = fmaxf(mx, __shfl_xor(mx, 32));
        float l = 0.f;
#pragma unroll
        for (int f = 0; f < 10; ++f)
#pragma unroll
            for (int r = 0; r < 4; ++r) { const float p = __builtin_amdgcn_exp2f(sc[f][r] - mx); sc[f][r] = p; l += p; }
        l += __shfl_xor(l, 16); l += __shfl_xor(l, 32);
        l += __builtin_amdgcn_exp2f(sink2 - mx);
        const float inv = 1.f / l;
        f32x4 oa[4];
#pragma unroll
        for (int d = 0; d < 4; ++d) oa[d] = (f32x4){0.f, 0.f, 0.f, 0.f};
#pragma unroll
        for (int kk = 0; kk < 5; ++kk) {
            const bf16x8 pf = pack8(sc[2 * kk][0], sc[2 * kk][1], sc[2 * kk][2], sc[2 * kk][3], sc[2 * kk + 1][0], sc[2 * kk + 1][1], sc[2 * kk + 1][2], sc[2 * kk + 1][3]);
#pragma unroll
            for (int d = 0; d < 4; ++d) {
                const LAS unsigned char* a0 = VL + (16 * (f0 + 2 * kk) + 4 * fq + q4) * AK_STRIDE + (16 * d + 4 * p4) * 2;
                const bf16x8 vf = cat8(tr_read(a0), tr_read(a0 + 16 * AK_STRIDE));
                oa[d] = MFMA16(vf, pf, oa[d]);
            }
        }
#pragma unroll
        for (int d = 0; d < 4; ++d) {
            const u32x2 gr = gcur[d];
            const float y0 = oa[d][0] * inv * silu(bf_lo(gr.x)), y1 = oa[d][1] * inv * silu(bf_hi(gr.x)), y2 = oa[d][2] * inv * silu(bf_lo(gr.y)), y3 = oa[d][3] * inv * silu(bf_hi(gr.y));
            u32x2 ow; ow.x = cvt_pk_bf16(y0, y1); ow.y = cvt_pk_bf16(y2, y3);
            *(u32x2*)(OG + tok * D + head * 64 + 16 * d + 4 * fq) = ow;
        }
    }
}
__device__ __forceinline__ void swa_sample_item(Ctx& F, int li, int item) {
    TIDS;
    const bf16_t* PROJ = (const bf16_t*)(F.ws + WS_PROJ); bf16_t* OG = (bf16_t*)(F.ws + WS_OG);
    const int b = item >> 1, kvh = item & 1, g = wave;
    LAS float* Kf = (LAS float*)F.lds;
    LAS float* Vf = Kf + 8400;
    LAS float* pb = Vf + 129 * 64;
    LAS float* qb = pb + 8 * 136;
    const bf16_t* row = PROJ + (size_t)(MP + b) * SWA_IN;
    __syncthreads();
    {
        const int u = tid >> 2, dq = tid & 3;
        const size_t ci = (((size_t)(li * 128 + b) * 128 + u) * 2 + kvh) * 64 + 16 * dq;
        const float* kc = F.in[3] + ci; const float* vc = F.in[4] + ci;
#pragma unroll
        for (int i = 0; i < 4; ++i) {
            const f32x4 k = *(const f32x4*)(kc + 4 * i), v = *(const f32x4*)(vc + 4 * i);
            Kf[u * 65 + 16 * dq + 4 * i + 0] = k.x; Kf[u * 65 + 16 * dq + 4 * i + 1] = k.y; Kf[u * 65 + 16 * dq + 4 * i + 2] = k.z; Kf[u * 65 + 16 * dq + 4 * i + 3] = k.w;
            *(LAS f32x4*)(Vf + u * 64 + 16 * dq + 4 * i) = v;
            if (u >= 1) { const size_t oi = (((size_t)(li * 128 + b) * 128 + (u - 1)) * 2 + kvh) * 64 + 16 * dq + 4 * i; *(f32x4*)(F.out + O_KS + oi) = k; *(f32x4*)(F.out + O_VS + oi) = v; }
        }
    }
    if (g == 0) {
        const float k = bf2f(row[1024 + kvh * 64 + lane]);
        const float kn = k * rsqrtf(wave_sum(k * k) * (1.f / 64.f) + EPS) * F.in[12][li * 64 + lane];
        Kf[128 * 65 + lane] = kn;
        F.out[O_KS + (((size_t)(li * 128 + b) * 128 + 127) * 2 + kvh) * 64 + lane] = kn;
    } else if (g == 1) {
        const float v = bf2f(row[1152 + kvh * 64 + lane]);
        Vf[128 * 64 + lane] = v;
        F.out[O_VS + (((size_t)(li * 128 + b) * 128 + 127) * 2 + kvh) * 64 + lane] = v;
    }
    const int head = kvh * 8 + g;
    {
        const float q = bf2f(row[head * 64 + lane]);
        qb[g * 64 + lane] = q * rsqrtf(wave_sum(q * q) * (1.f / 64.f) + EPS) * F.in[11][li * 64 + lane] * 0.125f;
    }
    __syncthreads();
    const float slope = exp2f(-0.5f * (float)(head + 1));
    const float sink = F.in[13][li * 16 + head];
    float s0 = 0.f, s1 = 0.f, s2 = 0.f;
#pragma unroll 8
    for (int d = 0; d < 64; ++d) { const float q = qb[g * 64 + d]; s0 += q * Kf[lane * 65 + d]; s1 += q * Kf[(lane + 64) * 65 + d]; s2 += q * Kf[128 * 65 + d]; }
    s0 -= slope * (float)(128 - lane); s1 -= slope * (float)(64 - lane);
    const float mx = fmaxf(fmaxf(wave_max(fmaxf(s0, s1)), s2), sink);
    const float e0 = __expf(s0 - mx), e1 = __expf(s1 - mx), e2 = __expf(s2 - mx);
    const float l = wave_sum(e0 + e1) + e2 + __expf(sink - mx);
    pb[g * 136 + lane] = e0; pb[g * 136 + 64 + lane] = e1; if (lane == 0) pb[g * 136 + 128] = e2;
    __syncthreads();
    float o = 0.f;
#pragma unroll 8
    for (int u = 0; u < 129; ++u) o += pb[g * 136 + u] * Vf[u * 64 + lane];
    o = o / l * silu(bf2f(row[1280 + head * 64 + lane]));
    OG[(size_t)(MP + b) * D + head * 64 + lane] = (bf16_t)(cvt_pk_bf16(o, 0.f) & 0xffffu);
}

__global__ void __launch_bounds__(512, 2) hybrid_fwd(Args args) {
    extern __shared__ __attribute__((aligned(16))) unsigned char lds_raw[];
    cg::grid_group grid = cg::this_grid();
    Ctx F;
    F.lds = (LAS unsigned char*)lds_raw;
    F.G = gridDim.x; F.bid = blockIdx.x; F.vcu = (F.G % 8 == 0) ? (F.bid % 8) * (F.G / 8) + F.bid / 8 : F.bid;
#pragma unroll
    for (int i = 0; i < 15; ++i) F.in[i] = args.in[i];
    F.out = args.out; F.ws = args.ws;
    bf16_t* H = (bf16_t*)(F.ws + WS_H); bf16_t* PROJ = (bf16_t*)(F.ws + WS_PROJ); bf16_t* OG = (bf16_t*)(F.ws + WS_OG);
    volatile LAS unsigned* MISC = (volatile LAS unsigned*)(F.lds + MISC_OFF);
    if (threadIdx.x < 16) MISC[threadIdx.x] = 0u;
    if (blockIdx.x == 0) { unsigned* bw = (unsigned*)(F.ws + WS_BAR); for (int i = threadIdx.x; i < 4096; i += 512) __hip_atomic_store(bw + i, 0u, __ATOMIC_RELAXED, __HIP_MEMORY_SCOPE_AGENT); }
    __syncthreads();
#define GRID_BAR() xcd_barrier(bar)
    float* yp = F.out + O_YP; float* ys = F.out + O_YS;

    phase_weights(F, 0, W_FIRST, F.bid * 8, F.G * 8);
    phase_norm(F, F.in[0], F.in[1], F.in[5]);
    grid.sync();
    const XcdBarrier bar = xcd_barrier_post((unsigned*)(F.ws + WS_BAR), MISC + 8);

#pragma unroll 1
    for (int layer = 0; layer < 4; ++layer) {
        const int li = layer >> 1;
        const float* xp = layer == 0 ? F.in[0] : yp; const float* xs = layer == 0 ? F.in[1] : ys;
        if ((layer & 1) == 0) {
            const bf16_t* Wi = (const bf16_t*)(F.ws + WS_WIN_RET) + (size_t)li * RET_IN * D; const bf16_t* Wo = (const bf16_t*)(F.ws + WS_WOUT_RET) + (size_t)li * D * RET_V;
            {
                pg8::Gemm g{H, Wi, MP, RET_IN, D}; pg8::StaticOrder S; S.init(MP, RET_IN, F.G, F.bid);
                pg8::EpiProjRet E{(bf16_t*)(F.ws + WS_QB), (bf16_t*)(F.ws + WS_KB), (bf16_t*)(F.ws + WS_VB), PROJ, RET_IN};
                pg8::gemm_phase<pg8::EpiProjRet, pg8::StaticOrder, true, true>(F.lds, g, S, E);
                small_gemm<D, 4>(F, H + (size_t)MP * D, Wi, RET_IN, [&](int r, int c, f32x4 v) {
                    if (c >= 1024 && c < 2048) v *= 0.0625f;
                    u32x2 o; o.x = cvt_pk_bf16(v[0], v[1]); o.y = cvt_pk_bf16(v[2], v[3]); *(u32x2*)(PROJ + (size_t)(MP + r) * RET_IN + c) = o; });
            }
            GRID_BAR();
            {
                const bool x8 = (F.G % 16 == 0); const int L = x8 ? F.G / 8 : F.G, x = x8 ? F.bid % 8 : 0, j = x8 ? F.bid / 8 : F.bid, hl = L / 2;
                const int nscan = x8 ? F.G / 2 : hl, nstream = x8 ? F.G / 2 : L - hl;
                if (j < hl) { for (int it = x * hl + j; it < 128; it += nscan) ret_scan_item(F, li, it); }
                else { for (int it = x * hl + (j - hl); it < 512; it += nstream) ret_sample_item(F, li, it);
                       if (layer == 0) { __syncthreads(); phase_weights(F, W_FIRST, W_ALL, (x * hl + (j - hl)) * 8, nstream * 8); } }
            }
            GRID_BAR();
            phase_ret_gate(F, li);
            GRID_BAR();
            {
                pg8::Gemm g{OG, Wo, MP, D, RET_V}; pg8::StaticOrder S; S.init(MP, D, F.G, F.bid);
                pg8::EpiRes E{xp, yp, D};
                pg8::gemm_phase<pg8::EpiRes, pg8::StaticOrder, true, true>(F.lds, g, S, E);
                small_gemm<RET_V, 2>(F, OG + (size_t)MP * RET_V, Wo, D, [&](int r, int c, f32x4 v) {
                    const f32x4 x = *(const f32x4*)(xs + (size_t)r * D + c); *(f32x4*)(ys + (size_t)r * D + c) = x + v; });
            }
            GRID_BAR();
        } else {
            const bf16_t* Wi = (const bf16_t*)(F.ws + WS_WIN_SWA) + (size_t)li * SWA_IN * D; const bf16_t* Wo = (const bf16_t*)(F.ws + WS_WOUT_SWA) + (size_t)li * D * D;
            {
                pg8::Gemm g{H, Wi, MP, SWA_IN, D}; pg8::StaticOrder S; S.init(MP, SWA_IN, F.G, F.bid);
                pg8::EpiProj E{PROJ, SWA_IN, 0, 0, 1.f};
                pg8::gemm_phase<pg8::EpiProj, pg8::StaticOrder, true, true>(F.lds, g, S, E);
                small_gemm<D, 4>(F, H + (size_t)MP * D, Wi, SWA_IN, [&](int r, int c, f32x4 v) {
                    u32x2 o; o.x = cvt_pk_bf16(v[0], v[1]); o.y = cvt_pk_bf16(v[2], v[3]); *(u32x2*)(PROJ + (size_t)(MP + r) * SWA_IN + c) = o; });
            }
            GRID_BAR();
            for (int it = F.vcu; it < 256; it += F.G) swa_prompt_item(F, li, it);
            for (int it = F.bid; it < 256; it += F.G) swa_sample_item(F, li, it);
            GRID_BAR();
            {
                pg8::Gemm g{OG, Wo, MP, D, D}; pg8::StaticOrder S; S.init(MP, D, F.G, F.bid);
                pg8::EpiRes E{xp, yp, D};
                pg8::gemm_phase<pg8::EpiRes, pg8::StaticOrder, true, true>(F.lds, g, S, E);
                small_gemm<D, 2>(F, OG + (size_t)MP * D, Wo, D, [&](int r, int c, f32x4 v) {
                    const f32x4 x = *(const f32x4*)(xs + (size_t)r * D + c); *(f32x4*)(ys + (size_t)r * D + c) = x + v; });
            }
            GRID_BAR();
        }
        if (layer < 3) {
            const float* gnext = ((layer + 1) & 1) ? F.in[9] + (size_t)((layer + 1) >> 1) * D : F.in[5] + (size_t)((layer + 1) >> 1) * D;
            phase_norm(F, yp, ys, gnext);
            GRID_BAR();
        }
    }
}

extern "C" void kernel_launch(void* const* d_in, const int* in_sizes, int n_in, void* d_out, int out_size, void* d_ws, size_t ws_size, hipStream_t stream) {
    static int grid = 0;
    if (grid == 0) {
        if (n_in != 15 || (size_t)out_size != O_END || ws_size < WS_END) { fprintf(stderr, "kernel_launch: unexpected shapes (n_in %d out %d ws %zu)\n", n_in, out_size, ws_size); grid = -1; return; }
        int dev = 0, cus = 0, per_cu = 0;
        if (hipGetDevice(&dev) != hipSuccess || hipDeviceGetAttribute(&cus, hipDeviceAttributeMultiprocessorCount, dev) != hipSuccess) { grid = -1; return; }
        if (hipFuncSetAttribute((const void*)hybrid_fwd, hipFuncAttributeMaxDynamicSharedMemorySize, LDS_BYTES) != hipSuccess) { fprintf(stderr, "kernel_launch: hipFuncSetAttribute failed\n"); grid = -1; return; }
        if (hipOccupancyMaxActiveBlocksPerMultiprocessor(&per_cu, (const void*)hybrid_fwd, 512, LDS_BYTES) != hipSuccess || per_cu < 1) { fprintf(stderr, "kernel_launch: occupancy query failed (%d)\n", per_cu); (void)hipGetLastError(); per_cu = 1; }
        grid = cus * per_cu;
    }
    if (grid < 0) return;
    Args a{};
    for (int i = 0; i < 15; ++i) a.in[i] = (const float*)d_in[i];
    a.out = (float*)d_out; a.ws = (unsigned char*)d_ws;
    void* kargs[] = {&a};
    hipError_t e = hipLaunchCooperativeKernel((const void*)hybrid_fwd, dim3(grid), dim3(512), kargs, LDS_BYTES, stream);
    if (e != hipSuccess) fprintf(stderr, "kernel_launch: cooperative launch failed: %s (grid %d)\n", hipGetErrorString(e), grid);
}
```

```cpp
#include <hip/hip_runtime.h>
#include <hip/hip_cooperative_groups.h>
#include <cstdio>
#include <cstdint>
namespace cg = cooperative_groups;

#define LAS __attribute__((address_space(3)))
typedef unsigned short bf16_t;
typedef short bf16x8 __attribute__((ext_vector_type(8)));
typedef short s16x4 __attribute__((ext_vector_type(4)));
typedef float f32x4 __attribute__((ext_vector_type(4)));
typedef float f32x2 __attribute__((ext_vector_type(2)));
typedef unsigned u32x4 __attribute__((ext_vector_type(4)));
typedef unsigned u32x2 __attribute__((ext_vector_type(2)));

constexpr int D = 1024, MP = 16384, MS = 128, MT = 16640, SEQ = 4096;
constexpr int RET_IN = 6144, SWA_IN = 2304, RET_V = 2048;
constexpr float EPS = 1e-6f;
constexpr float LOG2E = 1.4426950408889634f;

constexpr size_t O_YP = 0, O_YS = 16777216, O_RETP = 16908288, O_RETS = 21102592, O_KP = 155320320, O_VP = 155451392, O_KS = 155582464, O_VS = 159776768, O_END = 163971072;

constexpr size_t MiB = 1u << 20;
constexpr size_t WS_WIN_RET = 0, WS_WOUT_RET = 24 * MiB, WS_WIN_SWA = 32 * MiB, WS_WOUT_SWA = 41 * MiB, WS_H = 48 * MiB, WS_PROJ = 96 * MiB,
                 WS_P = 292 * MiB, WS_O = 308 * MiB, WS_OG = 376 * MiB, WS_BAR = 447 * MiB,
                 WS_QB = 448 * MiB  , WS_KB = 480 * MiB  , WS_VB = 512 * MiB  , WS_END = 576 * MiB;
constexpr int LDS_BYTES = 163840, MISC_OFF = 163840 - 256;

__device__ __forceinline__ unsigned cvt_pk_bf16(float lo, float hi) { unsigned r; asm volatile("v_cvt_pk_bf16_f32 %0, %1, %2" : "=v"(r) : "v"(lo), "v"(hi)); return r; }
__device__ __forceinline__ float bf_lo(unsigned u) { return __builtin_bit_cast(float, u << 16); }
__device__ __forceinline__ float bf_hi(unsigned u) { return __builtin_bit_cast(float, u & 0xffff0000u); }
__device__ __forceinline__ float bf2f(bf16_t b) { return __builtin_bit_cast(float, ((unsigned)b) << 16); }
__device__ __forceinline__ float wave_sum(float v) {
#pragma unroll
    for (int o = 1; o < 64; o <<= 1) v += __shfl_xor(v, o);
    return v;
}
__device__ __forceinline__ float wave_max(float v) {
#pragma unroll
    for (int o = 1; o < 64; o <<= 1) v = fmaxf(v, __shfl_xor(v, o));
    return v;
}
__device__ __forceinline__ float silu(float x) { return x / (1.f + __expf(-x)); }
__device__ __forceinline__ s16x4 tr_read(const LAS unsigned char* p) {
    typedef short v4i16_t __attribute__((ext_vector_type(4)));
    return __builtin_bit_cast(s16x4, __builtin_amdgcn_ds_read_tr16_b64_v4i16((LAS v4i16_t*)p));
}
__device__ __forceinline__ bf16x8 cat8(s16x4 a, s16x4 b) { bf16x8 r; r[0] = a[0]; r[1] = a[1]; r[2] = a[2]; r[3] = a[3]; r[4] = b[0]; r[5] = b[1]; r[6] = b[2]; r[7] = b[3]; return r; }
__device__ __forceinline__ bf16x8 pack8(float a0, float a1, float a2, float a3, float a4, float a5, float a6, float a7) {
    u32x4 w; w.x = cvt_pk_bf16(a0, a1); w.y = cvt_pk_bf16(a2, a3); w.z = cvt_pk_bf16(a4, a5); w.w = cvt_pk_bf16(a6, a7); return __builtin_bit_cast(bf16x8, w);
}
#define LDS_BARRIER() do { asm volatile("s_waitcnt lgkmcnt(0)" ::: "memory"); __builtin_amdgcn_s_barrier(); asm volatile("" ::: "memory"); } while (0)
#define MFMA16(a, b, c) __builtin_amdgcn_mfma_f32_16x16x32_bf16((a), (b), (c), 0, 0, 0)

namespace pg8 {
#define PG8_LAS __attribute__((address_space(3)))
constexpr int BM = 256, BK = 64, HALF = 128, HTB = HALF * BK * 2, STAGE_BYTES = 8 * HTB, NXCD = 8, WGM = 8;
__host__ __device__ __forceinline__ int lds_byte(int r, int c) { const int st = (r >> 4) * 2 + (c >> 5), rr = r & 15, cc = c & 31, ob = rr * 64 + cc * 2; return st * 1024 + (ob ^ (((ob >> 9) & 1) << 5)); }
__host__ __device__ __forceinline__ void stage_rc(int b, int& R, int& C) { const int st = b / 1024, sb = b % 1024, swz = sb ^ (((sb >> 9) & 1) << 5); R = (st >> 1) * 16 + swz / 64; C = (st & 1) * 32 + (swz % 64) / 2; }
__host__ __device__ __forceinline__ int perm32(int rho) { const int n = rho >> 4, i = rho & 15; return 8 * (i >> 2) + 4 * n + (i & 3); }
struct Unit { int pm, pn; };
struct Gemm { const bf16_t* A; const bf16_t* Bt; int M, N, K; };
struct StaticOrder {
    int nM, nN, nwg, G, c;
    __host__ __device__ void init(int M, int N, int G_, int c_) { nM = M / BM; nN = N / BM; nwg = nM * nN; G = G_; c = c_; }
    __host__ __device__ bool next(int i, Unit& u) const {
        const long L = (long)i * G + c; if (L >= nwg) return false;
        int wgid = (int)L; { const int q = nwg / NXCD, r = nwg % NXCD, xcd = wgid % NXCD, off = wgid / NXCD; wgid = (xcd < r ? xcd * (q + 1) : r * (q + 1) + (xcd - r) * q) + off; }
        const int nig = WGM * nN, gid = wgid / nig, fm = gid * WGM, gsz = (nM - fm) < WGM ? (nM - fm) : WGM;
        u.pm = fm + ((wgid % nig) % gsz); u.pn = (wgid % nig) / gsz; return true;
    }
    __device__ __forceinline__ void a_ready(const Unit&) const {}
    __device__ __forceinline__ void done(const Unit&) const {}
};
struct EpiProj {
    static constexpr bool PERM = true;
    bf16_t* O; int ldc; int sc_lo, sc_hi; float scale;
    __device__ __forceinline__ void operator()(const f32x4 (&acc)[2][2][4][2], const Unit& u, int wr, int wc, int fr, int fq) const {
        const int row0 = u.pm * BM + wr * 64 + fr; const int col0 = u.pn * BM + wc * 32 + 8 * fq;
        const float sc = (u.pn >= sc_lo && u.pn < sc_hi) ? scale : 1.f;
#pragma unroll
        for (int ai = 0; ai < 2; ++ai)
#pragma unroll
            for (int m = 0; m < 4; ++m) { bf16_t* rowp = O + (size_t)(row0 + ai * HALF + m * 16) * ldc + col0;
#pragma unroll
                for (int bj = 0; bj < 2; ++bj) { f32x4 v0 = acc[ai][bj][m][0] * sc, v1 = acc[ai][bj][m][1] * sc;
                    u32x4 w; w.x = cvt_pk_bf16(v0[0], v0[1]); w.y = cvt_pk_bf16(v0[2], v0[3]); w.z = cvt_pk_bf16(v1[0], v1[1]); w.w = cvt_pk_bf16(v1[2], v1[3]);
                    *(u32x4*)(rowp + bj * HALF) = w; } }
    }
};
struct EpiProjRet {
    static constexpr bool PERM = true;
    bf16_t* QB; bf16_t* KB; bf16_t* VB; bf16_t* G; int ldg;
    __device__ __forceinline__ void operator()(const f32x4 (&acc)[2][2][4][2], const Unit& u, int wr, int wc, int fr, int fq) const {
        const int pn = u.pn, t0 = wr * 64 + fr; const size_t tile0 = (size_t)((u.pm >> 4) * 32 + ((u.pm & 15) << 1)) * 4;
        const float sc = (pn >= 4 && pn < 8) ? 0.0625f : 1.f;
        bf16_t* base; size_t sa; int sm, sbj;
        if (pn < 8) { base = (pn < 4 ? QB : KB) + (tile0 + (pn & 3)) * 32768 + t0 * 256 + wc * 32 + 8 * fq; sa = 4 * 32768; sm = 16 * 256; sbj = HALF; }
        else if (pn < 16) { base = VB + ((tile0 + ((pn - 8) >> 1)) * 8 + (pn & 1) * 4 + (wc >> 1)) * 8192 + t0 * 64 + 32 * (wc & 1) + 8 * fq; sa = 4 * 8 * 8192; sm = 16 * 64; sbj = 2 * 8192; }
        else { base = G + (size_t)(u.pm * BM + t0) * ldg + pn * BM + wc * 32 + 8 * fq; sa = (size_t)HALF * ldg; sm = 16 * ldg; sbj = HALF; }
#pragma unroll
        for (int ai = 0; ai < 2; ++ai)
#pragma unroll
            for (int m = 0; m < 4; ++m) { bf16_t* rowp = base + ai * sa + (size_t)m * sm;
#pragma unroll
                for (int bj = 0; bj < 2; ++bj) { f32x4 v0 = acc[ai][bj][m][0] * sc, v1 = acc[ai][bj][m][1] * sc;
                    u32x4 w; w.x = cvt_pk_bf16(v0[0], v0[1]); w.y = cvt_pk_bf16(v0[2], v0[3]); w.z = cvt_pk_bf16(v1[0], v1[1]); w.w = cvt_pk_bf16(v1[2], v1[3]);
                    *(u32x4*)(rowp + bj * sbj) = w; } }
    }
};
struct EpiRes {
    static constexpr bool PERM = false;
    const float* X; float* Y; int ldc;
    __device__ __forceinline__ void operator()(const f32x4 (&acc)[2][2][4][2], const Unit& u, int wr, int wc, int fr, int fq) const {
        const int row0 = u.pm * BM + wr * 64 + fr, col0 = u.pn * BM + wc * 32 + 4 * fq;
#pragma unroll
        for (int ai = 0; ai < 2; ++ai)
#pragma unroll
            for (int m = 0; m < 4; ++m) { const size_t ro = (size_t)(row0 + ai * HALF + m * 16) * ldc + col0;
#pragma unroll
                for (int bj = 0; bj < 2; ++bj)
#pragma unroll
                    for (int n = 0; n < 2; ++n) { const size_t ix = ro + bj * HALF + n * 16; const f32x4 x = *(const f32x4*)(X + ix); *(f32x4*)(Y + ix) = x + acc[ai][bj][m][n]; } }
    }
};

template <class Epi, class Sched, bool ALIGN_EPI = false, bool SP2 = false>
__device__ __forceinline__ void gemm_phase(PG8_LAS unsigned char* lds, const Gemm g, const Sched& S, const Epi& E) {
    int tid = threadIdx.x; asm volatile("" : "+v"(tid));
    const int wid = __builtin_amdgcn_readfirstlane(tid >> 6), lane = tid & 63, wr = wid >> 2, wc = wid & 3, fr = lane & 15, fq = lane >> 4;
    const int K = g.K, nt = K / BK;
    unsigned voffA[2], voffB[2];
#pragma unroll
    for (int i = 0; i < 2; ++i) { int R, C; stage_rc(tid * 16 + i * 8192, R, C); const int Rb = Epi::PERM ? ((R & ~31) + perm32(R & 31)) : R;
        voffA[i] = (unsigned)(R * K + C) * 2u; voffB[i] = (unsigned)(Rb * K + C) * 2u; }
    const size_t kstep = (size_t)(BK * 2);
    const size_t hstep = (size_t)HALF * K * 2;
    const size_t tstep = 2 * hstep;
    const unsigned ldsw = (unsigned)wid * 1024u;
    const int aoff = lds_byte(wr * 64 + fr, fq * 8), boff = lds_byte(wc * 32 + fr, fq * 8);
#define PG8_SA(b, h) (((b) * 2 + (h)) * HTB)
#define PG8_SB(b, h) ((4 + (b) * 2 + (h)) * HTB)
#define PG8_STAGE(bufoff, gbase, voff) do { _Pragma("unroll") for (int _i = 0; _i < 2; ++_i) \
        __builtin_amdgcn_global_load_lds((const unsigned*)((const char*)(gbase) + (voff)[_i]), (PG8_LAS unsigned*)(lds + (bufoff) + ldsw + _i * 8192), 16, 0, 0); } while (0)
#define PG8_LDA(dst, b, h) do { _Pragma("unroll") for (int m = 0; m < 4; ++m) _Pragma("unroll") for (int k = 0; k < 2; ++k) dst[m][k] = *(const PG8_LAS bf16x8*)(lds + PG8_SA(b, h) + aoff + m * 2048 + k * 1024); } while (0)
#define PG8_LDB(dst, b, h) do { _Pragma("unroll") for (int n = 0; n < 2; ++n) _Pragma("unroll") for (int k = 0; k < 2; ++k) dst[n][k] = *(const PG8_LAS bf16x8*)(lds + PG8_SB(b, h) + boff + n * 2048 + k * 1024); } while (0)
#define PG8_MMA(ai, bj, At, Bt) do { __builtin_amdgcn_s_setprio(1); _Pragma("unroll") for (int m = 0; m < 4; ++m) _Pragma("unroll") for (int n = 0; n < 2; ++n) _Pragma("unroll") for (int k = 0; k < 2; ++k) \
        acc[ai][bj][m][n] = __builtin_amdgcn_mfma_f32_16x16x32_bf16(Bt[n][k], At[m][k], acc[ai][bj][m][n], 0, 0, 0); __builtin_amdgcn_s_setprio(0); } while (0)
#define PG8_WAIT_V(n) asm volatile("s_waitcnt vmcnt(" #n ")" ::: "memory")
#define PG8_WAIT_L(n) asm volatile("s_waitcnt lgkmcnt(" #n ")" ::: "memory")
#define PG8_BAR __builtin_amdgcn_s_barrier()
#define PG8_SCHED __builtin_amdgcn_sched_barrier(0)
    Unit cur, nxt; int ui = 0;
    if (!S.next(0, cur)) return;
    f32x4 acc[2][2][4][2];
#pragma unroll
    for (int a = 0; a < 2; ++a)
#pragma unroll
        for (int b = 0; b < 2; ++b)
#pragma unroll
            for (int m = 0; m < 4; ++m)
#pragma unroll
                for (int n = 0; n < 2; ++n) acc[a][b][m][n] = (f32x4){0.f, 0.f, 0.f, 0.f};
    bf16x8 At[4][2], B0[2][2], B1[2][2];
    const char* cA = (const char*)g.A + (size_t)cur.pm * tstep; const char* cB = (const char*)g.Bt + (size_t)cur.pn * tstep;
    S.a_ready(cur);
    if constexpr (SP2) {
        PG8_STAGE(PG8_SB(0, 0), cB, voffB); PG8_STAGE(PG8_SB(0, 1), cB + hstep, voffB); PG8_STAGE(PG8_SA(0, 0), cA, voffA); PG8_STAGE(PG8_SA(0, 1), cA + hstep, voffA);
        if (wr == 1) PG8_BAR;
        PG8_WAIT_V(2); PG8_BAR;
        PG8_STAGE(PG8_SB(1, 0), cB + kstep, voffB); PG8_STAGE(PG8_SA(1, 0), cA + kstep, voffA); PG8_STAGE(PG8_SB(1, 1), cB + hstep + kstep, voffB);
        PG8_WAIT_V(6); PG8_BAR;
    } else {
        PG8_STAGE(PG8_SB(0, 0), cB, voffB); PG8_STAGE(PG8_SA(0, 0), cA, voffA); PG8_STAGE(PG8_SB(0, 1), cB + hstep, voffB); PG8_STAGE(PG8_SA(0, 1), cA + hstep, voffA);
        if (wr == 1) PG8_BAR;
        PG8_WAIT_V(4); PG8_BAR;
        PG8_STAGE(PG8_SB(1, 0), cB + kstep, voffB); PG8_STAGE(PG8_SA(1, 0), cA + kstep, voffA); PG8_STAGE(PG8_SB(1, 1), cB + hstep + kstep, voffB);
        PG8_WAIT_V(6); PG8_BAR;
    }
    for (;;) {
        const bool has_next = S.next(ui + 1, nxt);
        const char* nA = has_next ? (const char*)g.A + (size_t)nxt.pm * tstep : cA; const char* nB = has_next ? (const char*)g.Bt + (size_t)nxt.pn * tstep : cB;
        for (int t = 0; t < nt; t += 2) {
            const bool last = (t == nt - 2);
            const char* a1 = cA + (size_t)(t + 1) * kstep;
            const char* a2 = last ? nA : cA + (size_t)(t + 2) * kstep; const char* b2 = last ? nB : cB + (size_t)(t + 2) * kstep;
            const char* a3 = a2 + kstep; const char* b3 = b2 + kstep;
            if (last && has_next) S.a_ready(nxt);
            if constexpr (SP2) {
            PG8_LDB(B0, 0, 0); PG8_LDB(B1, 0, 1); PG8_SCHED; PG8_LDA(At, 0, 0); PG8_STAGE(PG8_SA(1, 1), a1 + hstep, voffA);
            PG8_WAIT_V(8); PG8_WAIT_L(0); PG8_BAR; PG8_MMA(0, 0, At, B0); PG8_MMA(0, 1, At, B1); PG8_BAR; PG8_SCHED;
            PG8_LDA(At, 0, 1); PG8_STAGE(PG8_SB(0, 0), b2, voffB); PG8_STAGE(PG8_SB(0, 1), b2 + hstep, voffB); PG8_STAGE(PG8_SA(0, 0), a2, voffA);
            PG8_WAIT_V(8); PG8_WAIT_L(0); PG8_BAR; PG8_MMA(1, 0, At, B0); PG8_MMA(1, 1, At, B1); PG8_BAR; PG8_SCHED;
            PG8_LDB(B0, 1, 0); PG8_LDB(B1, 1, 1); PG8_SCHED; PG8_LDA(At, 1, 0); PG8_STAGE(PG8_SA(0, 1), a2 + hstep, voffA);
            PG8_WAIT_V(8); PG8_WAIT_L(0); PG8_BAR; PG8_MMA(0, 0, At, B0); PG8_MMA(0, 1, At, B1); PG8_BAR; PG8_SCHED;
            PG8_LDA(At, 1, 1); PG8_STAGE(PG8_SB(1, 0), b3, voffB); PG8_STAGE(PG8_SB(1, 1), b3 + hstep, voffB); PG8_STAGE(PG8_SA(1, 0), a3, voffA);
            PG8_WAIT_V(8); PG8_WAIT_L(0); PG8_BAR; PG8_MMA(1, 0, At, B0); PG8_MMA(1, 1, At, B1); PG8_BAR; PG8_SCHED;
            } else {
            PG8_LDB(B0, 0, 0); PG8_SCHED; PG8_LDA(At, 0, 0); PG8_STAGE(PG8_SA(1, 1), a1 + hstep, voffA);
            PG8_WAIT_L(8); PG8_BAR; PG8_WAIT_L(0); PG8_MMA(0, 0, At, B0); PG8_BAR; PG8_SCHED;
            PG8_LDB(B1, 0, 1); PG8_STAGE(PG8_SB(0, 0), b2, voffB);
            PG8_BAR; PG8_WAIT_L(0); PG8_MMA(0, 1, At, B1); PG8_BAR;
            PG8_LDA(At, 0, 1); PG8_STAGE(PG8_SA(0, 0), a2, voffA);
            PG8_BAR; PG8_WAIT_L(0); PG8_MMA(1, 0, At, B0); PG8_BAR; PG8_SCHED;
            PG8_STAGE(PG8_SB(0, 1), b2 + hstep, voffB);
            PG8_WAIT_V(6); PG8_BAR; PG8_MMA(1, 1, At, B1); PG8_BAR;
            PG8_LDB(B0, 1, 0); PG8_SCHED; PG8_LDA(At, 1, 0); PG8_STAGE(PG8_SA(0, 1), a2 + hstep, voffA);
            PG8_WAIT_L(8); PG8_BAR; PG8_WAIT_L(0); PG8_MMA(0, 0, At, B0); PG8_BAR; PG8_SCHED;
            PG8_LDB(B1, 1, 1); PG8_STAGE(PG8_SB(1, 0), b3, voffB);
            PG8_BAR; PG8_WAIT_L(0); PG8_MMA(0, 1, At, B1); PG8_BAR;
            PG8_LDA(At, 1, 1); PG8_STAGE(PG8_SA(1, 0), a3, voffA);
            PG8_BAR; PG8_WAIT_L(0); PG8_MMA(1, 0, At, B0); PG8_BAR; PG8_SCHED;
            PG8_STAGE(PG8_SB(1, 1), b3 + hstep, voffB);
            PG8_WAIT_V(6); PG8_BAR; PG8_MMA(1, 1, At, B1); PG8_BAR;
            }
        }
        if constexpr (ALIGN_EPI) { if (wr == 0) PG8_BAR; }
        E(acc, cur, wr, wc, fr, fq); S.done(cur);
        if (!has_next) break;
#pragma unroll
        for (int a = 0; a < 2; ++a)
#pragma unroll
            for (int b = 0; b < 2; ++b)
#pragma unroll
                for (int m = 0; m < 4; ++m)
#pragma unroll
                    for (int n = 0; n < 2; ++n) acc[a][b][m][n] = (f32x4){0.f, 0.f, 0.f, 0.f};
        cur = nxt; cA = nA; cB = nB; ++ui;
        if constexpr (ALIGN_EPI) { if (wr == 1) PG8_BAR; }
    }
    PG8_WAIT_V(0);
    if constexpr (!ALIGN_EPI) { if (wr == 0) PG8_BAR; }
    PG8_BAR;
#undef PG8_SA
#undef PG8_SB
#undef PG8_STAGE
#undef PG8_LDA
#undef PG8_LDB
#undef PG8_MMA
#undef PG8_WAIT_V
#undef PG8_WAIT_L
#undef PG8_BAR
#undef PG8_SCHED
}
}

#define XB_TMO      128
#define XB_XCNT(j)  (256  + 64 * (j))
#define XB_XSUB(j)  (1280 + 64 * (j))
#define XB_XGEN(j)  (2304 + 64 * (j))
#define XB_TOP      3328
#define XB_TOPGEN   3392
#define XCD_BAR_WORDS 3456
#define XB_SPIN_CAP (1u << 18)

__device__ __forceinline__ unsigned xb_ld(unsigned* p)              { return __hip_atomic_load(p, __ATOMIC_RELAXED, __HIP_MEMORY_SCOPE_AGENT); }
__device__ __forceinline__ unsigned xb_add(unsigned* p, unsigned v) { return __hip_atomic_fetch_add(p, v, __ATOMIC_RELAXED, __HIP_MEMORY_SCOPE_AGENT); }
__device__ __forceinline__ unsigned xb_xcc_id() { return (unsigned)__builtin_amdgcn_s_getreg((3 << 11) | 20) & 0xFu; }
#define XB_SPIN(cond, bar) do { unsigned _sp = 0; while (cond) { __builtin_amdgcn_s_sleep(1); \
    if ((++_sp & 255u) == 0u) { if (xb_ld(&(bar)[XB_TMO])) break; if (_sp > XB_SPIN_CAP) { atomicAdd(&(bar)[XB_TMO], 1u); break; } } } } while (0)

struct XcdBarrier {
    unsigned* bar; unsigned x;
    volatile LAS unsigned* st;
};

__device__ __forceinline__ XcdBarrier xcd_barrier_post(unsigned* bar, volatile LAS unsigned* st) {
    XcdBarrier b; b.bar = bar; b.x = xb_xcc_id(); b.st = st;
    if (threadIdx.x == 0) (void)xb_add(&bar[XB_XCNT(b.x)], 1u);
    return b;
}
__device__ __forceinline__ void xcd_barrier_complete(unsigned* bar, unsigned x, unsigned& nloc, unsigned& nx) {
    const unsigned G = gridDim.x * gridDim.y * gridDim.z;
    unsigned sum, cnt, mine, sp = 0u;
    for (;;) {
        sum = 0u; cnt = 0u; mine = 0u;
#pragma unroll
        for (unsigned j = 0; j < 16; ++j) { const unsigned c = xb_ld(&bar[XB_XCNT(j)]); sum += c; cnt += (c > 0u) ? 1u : 0u; mine = (j == x) ? c : mine; }
        if (sum == G) break;
        __builtin_amdgcn_s_sleep(1);
        if ((++sp & 255u) == 0u) { if (xb_ld(&bar[XB_TMO])) break; if (sp > XB_SPIN_CAP) { atomicAdd(&bar[XB_TMO], 1u); break; } }
    }
    nloc = mine > 0u ? mine : 1u; nx = cnt > 0u ? cnt : 1u;
}

__device__ __forceinline__ void xcd_barrier(const XcdBarrier& b) {
    asm volatile("s_waitcnt vmcnt(0)" ::: "memory");
    __syncthreads();
    if (threadIdx.x == 0) {
        unsigned* bar = b.bar;
        __builtin_amdgcn_s_waitcnt(0);
        unsigned nloc = b.st[0], nx = b.st[1];
        if (nloc == 0u) { xcd_barrier_complete(bar, b.x, nloc, nx); b.st[0] = nloc; b.st[1] = nx; }
        const unsigned old = xb_add(&bar[XB_XSUB(b.x)], 1u);
        const unsigned gen = old / nloc;
        if (old + 1u == (gen + 1u) * nloc) {
            __builtin_amdgcn_fence(__ATOMIC_RELEASE, "agent");
            asm volatile("s_waitcnt vmcnt(0)" ::: "memory");
            const unsigned og = xb_add(&bar[XB_TOP], 1u);
            const unsigned tg = og / nx;
            if (og + 1u == (tg + 1u) * nx) xb_add(&bar[XB_TOPGEN], 1u);
            else XB_SPIN(xb_ld(&bar[XB_TOPGEN]) == tg, bar);
            __builtin_amdgcn_fence(__ATOMIC_ACQUIRE, "agent");
            xb_add(&bar[XB_XGEN(b.x)], 1u);
            asm volatile("s_waitcnt vmcnt(0)" ::: "memory");
        } else {
            XB_SPIN(xb_ld(&bar[XB_XGEN(b.x)]) == gen, bar);
            __builtin_amdgcn_fence(__ATOMIC_ACQUIRE, "agent");
            asm volatile("s_waitcnt vmcnt(0)" ::: "memory");
        }
    }
    __syncthreads();
}

struct Args { const float* in[15]; float* out; unsigned char* ws; };

#define TIDS int tid = threadIdx.x; asm volatile("" : "+v"(tid)); const int lane = tid & 63, wave = __builtin_amdgcn_readfirstlane(tid >> 6); (void)lane; (void)wave
struct Ctx {
    LAS unsigned char* lds;
    int G, bid, vcu;
    const float* in[15]; float* out; unsigned char* ws;
};

constexpr int W_FIRST = 16 * 192 + 32 * 32, W_ALL = 2 * (16 * 192 + 32 * 32 + 16 * 72 + 16 * 32);
__device__ __forceinline__ void transpose_item(const float* W, int K, int N, bf16_t* WT, LAS float* scr, int item, int lane) {
    const int nblk = N / 32, kb = item / nblk, nb = item % nblk, k0 = 64 * kb, n0 = 32 * nb;
#pragma unroll 8
    for (int i = 0; i < 32; ++i) { const int kk = 2 * i + (lane >> 5); scr[kk * 33 + (lane & 31)] = W[(size_t)(k0 + kk) * N + n0 + (lane & 31)]; }
    asm volatile("s_waitcnt lgkmcnt(0)" ::: "memory");
    const int c = lane & 7;
#pragma unroll
    for (int j = 0; j < 4; ++j) { const int n = (lane >> 3) + 8 * j; const LAS float* s = scr + (8 * c) * 33 + n;
        u32x4 o; o.x = cvt_pk_bf16(s[0 * 33], s[1 * 33]); o.y = cvt_pk_bf16(s[2 * 33], s[3 * 33]); o.z = cvt_pk_bf16(s[4 * 33], s[5 * 33]); o.w = cvt_pk_bf16(s[6 * 33], s[7 * 33]);
        *(u32x4*)(WT + (size_t)(n0 + n) * K + k0 + 8 * c) = o; }
    asm volatile("s_waitcnt lgkmcnt(0)" ::: "memory");
}
__device__ __forceinline__ void phase_weights(Ctx& F, int lo, int hi, int gwb, int NGW) {
    TIDS;
    LAS float* scr = (LAS float*)(F.lds + wave * 16384);
    const int gw = gwb + wave;
    constexpr int I_RI = 16 * 192, I_RO = 32 * 32, I_SI = 16 * 72, I_SO = 16 * 32, PER = I_RI + I_RO + I_SI + I_SO;
    for (int it = lo + gw; it < hi; it += NGW) {
        const int li = it / PER; int r = it % PER;
        if (r < I_RI) { transpose_item(F.in[6] + (size_t)li * D * RET_IN, D, RET_IN, (bf16_t*)(F.ws + WS_WIN_RET) + (size_t)li * RET_IN * D, scr, r, lane); continue; } r -= I_RI;
        if (r < I_RO) { transpose_item(F.in[8] + (size_t)li * RET_V * D, RET_V, D, (bf16_t*)(F.ws + WS_WOUT_RET) + (size_t)li * D * RET_V, scr, r, lane); continue; } r -= I_RO;
        if (r < I_SI) { transpose_item(F.in[10] + (size_t)li * D * SWA_IN, D, SWA_IN, (bf16_t*)(F.ws + WS_WIN_SWA) + (size_t)li * SWA_IN * D, scr, r, lane); continue; } r -= I_SI;
        transpose_item(F.in[14] + (size_t)li * D * D, D, D, (bf16_t*)(F.ws + WS_WOUT_SWA) + (size_t)li * D * D, scr, r, lane);
    }
}
__device__ __forceinline__ void phase_norm(Ctx& F, const float* xp, const float* xs, const float* g) {
    TIDS;
    bf16_t* H = (bf16_t*)(F.ws + WS_H);
    const int gw = F.bid * 8 + wave, NGW = F.G * 8;
    f32x4 gv[4];
#pragma unroll
    for (int j = 0; j < 4; ++j) gv[j] = *((const f32x4*)g + lane + 64 * j);
    for (int r0 = gw; r0 < MP + MS; r0 += 2 * NGW) {
        const int r1 = r0 + NGW; const bool has1 = r1 < MP + MS; const int r1c = has1 ? r1 : r0;
        const float* s0 = r0 < MP ? xp + (size_t)r0 * D : xs + (size_t)(r0 - MP) * D;
        const float* s1 = r1c < MP ? xp + (size_t)r1c * D : xs + (size_t)(r1c - MP) * D;
        f32x4 v[4], u[4]; float a = 0.f, b = 0.f;
#pragma unroll
        for (int j = 0; j < 4; ++j) { v[j] = ((const f32x4*)s0 + lane)[64 * j]; u[j] = ((const f32x4*)s1 + lane)[64 * j]; }
#pragma unroll
        for (int j = 0; j < 4; ++j) { a += (v[j].x * v[j].x + v[j].y * v[j].y) + (v[j].z * v[j].z + v[j].w * v[j].w); b += (u[j].x * u[j].x + u[j].y * u[j].y) + (u[j].z * u[j].z + u[j].w * u[j].w); }
#pragma unroll
        for (int o = 1; o < 64; o <<= 1) { a += __shfl_xor(a, o); b += __shfl_xor(b, o); }
        const float ra = rsqrtf(a * (1.f / D) + EPS), rb = rsqrtf(b * (1.f / D) + EPS);
        u32x2* o0 = (u32x2*)(H + (size_t)r0 * D) + lane; u32x2* o1 = (u32x2*)(H + (size_t)r1c * D) + lane;
#pragma unroll
        for (int j = 0; j < 4; ++j) { f32x4 y = v[j] * ra * gv[j]; u32x2 w; w.x = cvt_pk_bf16(y.x, y.y); w.y = cvt_pk_bf16(y.z, y.w); o0[64 * j] = w; }
        if (has1) {
#pragma unroll
            for (int j = 0; j < 4; ++j) { f32x4 y = u[j] * rb * gv[j]; u32x2 w; w.x = cvt_pk_bf16(y.x, y.y); w.y = cvt_pk_bf16(y.z, y.w); o1[64 * j] = w; }
        }
    }
}

template <int K, int RM, class EF>
__device__ __forceinline__ void small_gemm(Ctx& F, const bf16_t* A, const bf16_t* Bt, int N, EF epi) {
    TIDS;
    constexpr int KW = K / 8, PST = 68, ROWS = 16 * RM, RB = 128 / ROWS;
    const int fr = lane & 15, fq = lane >> 4, nU = (N / 64) * RB;
    LAS float* part = (LAS float*)F.lds;
    for (int u = F.G - 1 - F.bid; u < nU; u += F.G) {
        const int n0 = (u / RB) * 64, r0 = (u % RB) * ROWS;
        const bf16x8* ap = (const bf16x8*)(A + (size_t)(r0 + fr) * K + wave * KW + 8 * fq);
        const bf16x8* bp = (const bf16x8*)(Bt + (size_t)(n0 + fr) * K + wave * KW + 8 * fq);
        f32x4 acc[RM][4];
#pragma unroll
        for (int m = 0; m < RM; ++m)
#pragma unroll
            for (int n = 0; n < 4; ++n) acc[m][n] = (f32x4){0.f, 0.f, 0.f, 0.f};
#pragma unroll 2
        for (int k = 0; k < KW / 32; ++k) {
            bf16x8 a[RM], bb[4];
#pragma unroll
            for (int m = 0; m < RM; ++m) a[m] = ap[(size_t)m * 16 * K / 8 + 4 * k];
#pragma unroll
            for (int n = 0; n < 4; ++n) bb[n] = bp[(size_t)n * 16 * K / 8 + 4 * k];
#pragma unroll
            for (int m = 0; m < RM; ++m)
#pragma unroll
                for (int n = 0; n < 4; ++n) acc[m][n] = MFMA16(bb[n], a[m], acc[m][n]);
        }
        __syncthreads();
#pragma unroll
        for (int m = 0; m < RM; ++m)
#pragma unroll
            for (int n = 0; n < 4; ++n) *(LAS f32x4*)(part + (wave * ROWS + 16 * m + fr) * PST + 16 * n + 4 * fq) = acc[m][n];
        __syncthreads();
#pragma unroll
        for (int q = 0; q < (ROWS * 16) / 512; ++q) {
            const int g = q * 512 + tid, row = g >> 4, c4 = (g & 15) * 4;
            f32x4 sm = {0.f, 0.f, 0.f, 0.f};
#pragma unroll
            for (int w8 = 0; w8 < 8; ++w8) sm += *(LAS f32x4*)(part + (w8 * ROWS + row) * PST + c4);
            epi(r0 + row, n0 + c4, sm);
        }
    }
}

constexpr int PK_STRIDE = 528;
__device__ __forceinline__ void ret_P_item(Ctx& F, int item) {
    TIDS;
    const bf16_t* PROJ = (const bf16_t*)(F.ws + WS_PROJ); bf16_t* P = (bf16_t*)(F.ws + WS_P) + (size_t)item * 16384;
    const int b = item >> 7, h = (item >> 5) & 3, c = item & 31, fr = lane & 15, fq = lane >> 4, w = wave;
    const int tile_ = (b * 32 + c) * 4 + h;
    const float l2g = log2f(1.f - exp2f(-5.f - (float)h));
    LAS unsigned char* KL = F.lds;
    u32x4 kreg[8]; bf16x8 qreg[8];
#pragma unroll
    for (int i = 0; i < 8; ++i) kreg[i] = *((const u32x4*)((const bf16_t*)(F.ws + WS_KB) + (size_t)tile_ * 32768) + i * 512 + tid);
    const bf16x8* qp = (const bf16x8*)((const bf16_t*)(F.ws + WS_QB) + (size_t)tile_ * 32768 + (16 * w + fr) * 256 + 8 * fq);
#pragma unroll
    for (int ks = 0; ks < 8; ++ks) qreg[ks] = qp[4 * ks];
    __syncthreads();
#pragma unroll
    for (int i = 0; i < 8; ++i) { const int cid = i * 512 + tid, s_ = cid >> 5, ch = cid & 31; *(LAS u32x4*)(KL + s_ * PK_STRIDE + 16 * ch) = kreg[i]; }
    __syncthreads();
    f32x4 acc[8];
#pragma unroll
    for (int n = 0; n < 8; ++n) acc[n] = (f32x4){0.f, 0.f, 0.f, 0.f};
#pragma unroll
    for (int ks = 0; ks < 8; ++ks) {
#pragma unroll
        for (int n = 0; n < 8; ++n) if (n <= w) { const bf16x8 k = *(const LAS bf16x8*)(KL + (16 * n + fr) * PK_STRIDE + (32 * ks + 8 * fq) * 2); acc[n] = MFMA16(k, qreg[ks], acc[n]); }
    }
    const int t = 16 * w + fr;
#pragma unroll
    for (int n = 0; n < 8; ++n) {
        float v[4];
#pragma unroll
        for (int r = 0; r < 4; ++r) { const int s_ = 16 * n + 4 * fq + r; v[r] = (t >= s_) ? acc[n][r] * exp2f(l2g * (float)(t - s_)) : 0.f; }
        u32x2 o; o.x = cvt_pk_bf16(v[0], v[1]); o.y = cvt_pk_bf16(v[2], v[3]);
        *(u32x2*)(P + t * 128 + 16 * n + 4 * fq) = o;
    }
}
__device__ __forceinline__ void ret_sample_item(Ctx& F, int li, int item) {
    TIDS;
    const bf16_t* PROJ = (const bf16_t*)(F.ws + WS_PROJ); bf16_t* O = (bf16_t*)(F.ws + WS_O);
    const int b = item >> 2, h = item & 3;
    LAS float* qk = (LAS float*)F.lds;
    LAS float* red = (LAS float*)F.lds + 512;
    const bf16_t* row = PROJ + (size_t)(MP + b) * RET_IN;
    __syncthreads();
    qk[tid] = bf2f(row[(tid < 256 ? 0 : 1024 - 256) + h * 256 + tid]);
    __syncthreads();
    const int eq = tid & 127, dg = tid >> 7;
    const float gam = 1.f - exp2f(-5.f - (float)h);
    const u32x2 vraw = *(const u32x2*)(row + 2048 + h * 512 + 4 * eq);
    const f32x4 v4 = {bf_lo(vraw.x), bf_hi(vraw.x), bf_lo(vraw.y), bf_hi(vraw.y)};
    const size_t sbase = ((size_t)(li * 128 + b) * 4 + h) * 131072;
    const f32x4* Sin = (const f32x4*)(F.in[2] + sbase) + eq; f32x4* Sout = (f32x4*)(F.out + O_RETS + sbase) + eq;
    f32x4 o4 = {0.f, 0.f, 0.f, 0.f};
    {
        f32x4 buf[16];
        const f32x4* Sr = Sin + (size_t)dg * 64 * 128; f32x4* Sw = Sout + (size_t)dg * 64 * 128;
#pragma unroll
        for (int i = 0; i < 16; ++i) buf[i] = __builtin_nontemporal_load(Sr + i * 128);
#pragma unroll
        for (int i = 0; i < 64; ++i) {
            const int d = dg * 64 + i;
            const f32x4 sn = buf[i & 15] * gam + v4 * qk[256 + d];
            if (i + 16 < 64) buf[i & 15] = __builtin_nontemporal_load(Sr + (i + 16) * 128);
            __builtin_nontemporal_store(sn, Sw + i * 128);
            o4 += sn * qk[d];
        }
    }
    *(LAS f32x4*)(red + dg * 512 + 4 * eq) = o4;
    __syncthreads();
    if (tid < 128) {
        f32x4 s = *(LAS f32x4*)(red + 4 * tid) + *(LAS f32x4*)(red + 512 + 4 * tid) + *(LAS f32x4*)(red + 1024 + 4 * tid) + *(LAS f32x4*)(red + 1536 + 4 * tid);
        u32x2 o; o.x = cvt_pk_bf16(s.x, s.y); o.y = cvt_pk_bf16(s.z, s.w);
        *(u32x2*)(O + (size_t)(MP + b) * RET_V + h * 512 + 4 * tid) = o;
    }
}
constexpr int KL_STRIDE = 544, KL_OFF = 0, VL_STRIDE = 144, VL_OFF = 69632, VDL_OFF = 88064, STL_OFF = 106496, STL_STRIDE = 528;
__device__ __forceinline__ void ret_scan_item(Ctx& F, int li, int item) {
    TIDS;
    bf16_t* O = (bf16_t*)(F.ws + WS_O);
    const int b = item >> 5, h = (item >> 3) & 3, es = item & 7, e0 = es * 64;
    const int fr = lane & 15, fq = lane >> 4, q4 = fr >> 2, p4 = fr & 3;
    const float l2g = log2f(1.f - exp2f(-5.f - (float)h));
    LAS unsigned char* KL = F.lds + KL_OFF; LAS unsigned char* VL = F.lds + VL_OFF; LAS unsigned char* VDL = F.lds + VDL_OFF; LAS unsigned char* STL = F.lds + STL_OFF;
    const size_t tokb = (size_t)b * SEQ;
    const bf16_t* QBp = (const bf16_t*)(F.ws + WS_QB); const bf16_t* KBp = (const bf16_t*)(F.ws + WS_KB); const bf16_t* VBp = (const bf16_t*)(F.ws + WS_VB);
    const int tileb = (b * 32) * 4 + h;
    __syncthreads();
    for (int i = tid; i < 64 * STL_STRIDE / 4; i += 512) ((LAS unsigned*)STL)[i] = 0u;
    if (wave < 4) {
        const int t0 = 16 * wave + fr, t1 = 16 * (7 - wave) + fr, dT = t1 - t0;
        __builtin_amdgcn_s_setprio(2);
        const float cross0 = exp2f(l2g * (float)(t0 + 1)), cross1 = exp2f(l2g * (float)(t1 + 1));
        const bf16_t* Qb = QBp + (size_t)tileb * 32768 + t0 * 256 + 8 * fq;
        bf16x8 qreg[2][8];
#pragma unroll
        for (int tt = 0; tt < 2; ++tt) {
#pragma unroll
            for (int ks = 0; ks < 8; ++ks) qreg[tt][ks] = *(const bf16x8*)(Qb + tt * dT * 256 + 32 * ks);
        }
        const float gt0 = exp2f(l2g * (float)t0), gt1 = exp2f(l2g * (float)t1);
        float gsr[4], gn[8];
#pragma unroll
        for (int r = 0; r < 4; ++r) gsr[r] = exp2f(-l2g * (float)(4 * fq + r));
#pragma unroll
        for (int n = 0; n < 8; ++n) gn[n] = exp2f(-l2g * (float)(16 * n));
        const int nmax0 = wave, nmax1 = 7 - wave;
#pragma unroll 1
        for (int c = 0; c < 32; ++c) {
            LDS_BARRIER();
            f32x4 aS[2][4];
#pragma unroll
            for (int tt = 0; tt < 2; ++tt)
#pragma unroll
                for (int e = 0; e < 4; ++e) aS[tt][e] = (f32x4){0.f, 0.f, 0.f, 0.f};
#pragma unroll
            for (int ks = 0; ks < 8; ++ks) {
#pragma unroll
                for (int e = 0; e < 4; ++e) {
                    const bf16x8 sf = *(const LAS bf16x8*)(STL + (16 * e + fr) * STL_STRIDE + (32 * ks + 8 * fq) * 2);
                    aS[0][e] = MFMA16(sf, qreg[0][ks], aS[0][e]); aS[1][e] = MFMA16(sf, qreg[1][ks], aS[1][e]);
                }
            }
            bf16x8 pf[2][4];
            {
                f32x4 pa[2][8];
#pragma unroll
                for (int tt = 0; tt < 2; ++tt)
#pragma unroll
                    for (int n = 0; n < 8; ++n) pa[tt][n] = (f32x4){0.f, 0.f, 0.f, 0.f};
#pragma unroll
                for (int ks = 0; ks < 8; ++ks) {
#pragma unroll
                    for (int n = 0; n < 8; ++n) if (n <= nmax1) {
                        const bf16x8 kfr = *(const LAS bf16x8*)(KL + (16 * n + fr) * KL_STRIDE + (32 * ks + 8 * fq) * 2);
                        if (n <= nmax0) pa[0][n] = MFMA16(kfr, qreg[0][ks], pa[0][n]);
                        pa[1][n] = MFMA16(kfr, qreg[1][ks], pa[1][n]);
                    }
                }
                const int cn = c < 31 ? c + 1 : 31;
#pragma unroll
                for (int tt = 0; tt < 2; ++tt) {
#pragma unroll
                    for (int ks = 0; ks < 8; ++ks) qreg[tt][ks] = *(const bf16x8*)(Qb + (size_t)cn * 4 * 32768 + tt * dT * 256 + 32 * ks);
                }
                float gt0l = gt0, gt1l = gt1; int t0l = t0;
                asm volatile("" : "+v"(gt0l), "+v"(gt1l), "+v"(t0l));
#pragma unroll
                for (int tt = 0; tt < 2; ++tt) {
                    const int t = t0l + tt * dT; const float gt = tt ? gt1l : gt0l;
#pragma unroll
                    for (int n = 0; n < 8; ++n)
#pragma unroll
                        for (int r = 0; r < 4; ++r) { const int s_ = 16 * n + 4 * fq + r; pa[tt][n][r] = (t >= s_) ? pa[tt][n][r] * (gt * gn[n] * gsr[r]) : 0.f; }
#pragma unroll
                    for (int kk = 0; kk < 4; ++kk) pf[tt][kk] = pack8(pa[tt][2 * kk][0], pa[tt][2 * kk][1], pa[tt][2 * kk][2], pa[tt][2 * kk][3], pa[tt][2 * kk + 1][0], pa[tt][2 * kk + 1][1], pa[tt][2 * kk + 1][2], pa[tt][2 * kk + 1][3]);
                }
            }
            f32x4 aP[2][4];
#pragma unroll
            for (int tt = 0; tt < 2; ++tt)
#pragma unroll
                for (int e = 0; e < 4; ++e) aP[tt][e] = (f32x4){0.f, 0.f, 0.f, 0.f};
#pragma unroll
            for (int kk = 0; kk < 4; ++kk) if (2 * kk <= nmax1) {
#pragma unroll
                for (int e = 0; e < 4; ++e) {
                    const LAS unsigned char* a0 = VL + (32 * kk + 4 * fq + q4) * VL_STRIDE + (16 * e + 4 * p4) * 2;
                    const bf16x8 vf = cat8(tr_read(a0), tr_read(a0 + 16 * VL_STRIDE));
                    if (2 * kk <= nmax0) aP[0][e] = MFMA16(vf, pf[0][kk], aP[0][e]);
                    aP[1][e] = MFMA16(vf, pf[1][kk], aP[1][e]);
                }
            }
            const size_t tok0 = tokb + c * 128;
#pragma unroll
            for (int tt = 0; tt < 2; ++tt)
#pragma unroll
                for (int e = 0; e < 4; ++e) {
                    const f32x4 o = aP[tt][e] + aS[tt][e] * (tt ? cross1 : cross0);
                    u32x2 ow; ow.x = cvt_pk_bf16(o[0], o[1]); ow.y = cvt_pk_bf16(o[2], o[3]);
                    *(u32x2*)(O + (tok0 + t0 + tt * dT) * RET_V + h * 512 + e0 + 16 * e + 4 * fq) = ow;
                }
            LDS_BARRIER();
        }
        __builtin_amdgcn_s_setprio(0);
    } else {
        const int gwv = wave - 4, gtid = tid - 256;
        const float cdec = exp2f(l2g * 128.f);
        f32x4 S[4][4];
#pragma unroll
        for (int a = 0; a < 4; ++a)
#pragma unroll
            for (int e = 0; e < 4; ++e) S[a][e] = (f32x4){0.f, 0.f, 0.f, 0.f};
        u32x4 kreg[16], vreg[4];
#pragma unroll
        for (int i = 0; i < 16; ++i) kreg[i] = *((const u32x4*)(KBp + (size_t)tileb * 32768) + i * 256 + gtid);
#pragma unroll
        for (int i = 0; i < 4; ++i) vreg[i] = *((const u32x4*)(VBp + ((size_t)tileb * 8 + es) * 8192) + i * 256 + gtid);
#pragma unroll 1
        for (int c = 0; c < 32; ++c) {
#pragma unroll
            for (int i = 0; i < 16; ++i) { const int cid = i * 256 + gtid, s_ = cid >> 5, ch = cid & 31; *(LAS u32x4*)(KL + s_ * KL_STRIDE + 16 * ch) = kreg[i]; }
#pragma unroll
            for (int i = 0; i < 4; ++i) { const int cid = i * 256 + gtid, s_ = cid >> 3, ch = cid & 7;
              *(LAS u32x4*)(VL + s_ * VL_STRIDE + 16 * ch) = vreg[i];
              const float dk = exp2f(l2g * (float)(127 - s_));
              u32x4 vd; vd.x = cvt_pk_bf16(bf_lo(vreg[i].x) * dk, bf_hi(vreg[i].x) * dk); vd.y = cvt_pk_bf16(bf_lo(vreg[i].y) * dk, bf_hi(vreg[i].y) * dk);
              vd.z = cvt_pk_bf16(bf_lo(vreg[i].z) * dk, bf_hi(vreg[i].z) * dk); vd.w = cvt_pk_bf16(bf_lo(vreg[i].w) * dk, bf_hi(vreg[i].w) * dk);
              *(LAS u32x4*)(VDL + s_ * VL_STRIDE + 16 * ch) = vd; }
            LDS_BARRIER();
            const int cn = c < 31 ? c + 1 : 31;
#pragma unroll
            for (int i = 0; i < 16; ++i) kreg[i] = *((const u32x4*)(KBp + (size_t)(tileb + 4 * cn) * 32768) + i * 256 + gtid);
#pragma unroll
            for (int i = 0; i < 4; ++i) vreg[i] = *((const u32x4*)(VBp + ((size_t)(tileb + 4 * cn) * 8 + es) * 8192) + i * 256 + gtid);
#pragma unroll
            for (int a = 0; a < 4; ++a)
#pragma unroll
                for (int e = 0; e < 4; ++e) S[a][e] *= cdec;
#pragma unroll
            for (int ks = 0; ks < 4; ++ks) {
                bf16x8 kf[4], vf[4];
#pragma unroll
                for (int a = 0; a < 4; ++a) { const LAS unsigned char* a0 = KL + (32 * ks + 8 * fq + q4) * KL_STRIDE + (64 * gwv + 16 * a + 4 * p4) * 2; kf[a] = cat8(tr_read(a0), tr_read(a0 + 4 * KL_STRIDE)); }
#pragma unroll
                for (int e = 0; e < 4; ++e) { const LAS unsigned char* a0 = VDL + (32 * ks + 8 * fq + q4) * VL_STRIDE + (16 * e + 4 * p4) * 2; vf[e] = cat8(tr_read(a0), tr_read(a0 + 4 * VL_STRIDE)); }
#pragma unroll
                for (int a = 0; a < 4; ++a)
#pragma unroll
                    for (int e = 0; e < 4; ++e) S[a][e] = MFMA16(kf[a], vf[e], S[a][e]);
            }
            LDS_BARRIER();
#pragma unroll
            for (int a = 0; a < 4; ++a)
#pragma unroll
                for (int e = 0; e < 4; ++e) { u32x2 sw; sw.x = cvt_pk_bf16(S[a][e][0], S[a][e][1]); sw.y = cvt_pk_bf16(S[a][e][2], S[a][e][3]);
                    *(LAS u32x2*)(STL + (16 * e + fr) * STL_STRIDE + (64 * gwv + 16 * a + 4 * fq) * 2) = sw; }
        }
        float* So = F.out + O_RETP + ((size_t)(li * 4 + b) * 4 + h) * 131072;
#pragma unroll
        for (int a = 0; a < 4; ++a)
#pragma unroll
            for (int e = 0; e < 4; ++e)
#pragma unroll
                for (int r = 0; r < 4; ++r) So[(size_t)(64 * gwv + 16 * a + 4 * fq + r) * 512 + e0 + 16 * e + fr] = S[a][e][r];
    }
}
__device__ __forceinline__ void phase_ret_gate(Ctx& F, int li) {
    TIDS;
    const bf16_t* PROJ = (const bf16_t*)(F.ws + WS_PROJ); const bf16_t* O = (const bf16_t*)(F.ws + WS_O); bf16_t* OG = (bf16_t*)(F.ws + WS_OG);
    const float* gn = F.in[7] + (size_t)li * RET_V;
    const int gw = F.bid * 8 + wave, NGW = F.G * 8;
    f32x4 gg[4][2];
#pragma unroll
    for (int h = 0; h < 4; ++h) { gg[h][0] = *(const f32x4*)(gn + h * 512 + 8 * lane); gg[h][1] = *(const f32x4*)(gn + h * 512 + 8 * lane + 4); }
    for (int row0 = gw; row0 < MP + MS; row0 += 2 * NGW) {
        const int row1 = row0 + NGW; const bool has1 = row1 < MP + MS;
        const int rows[2] = {row0, has1 ? row1 : row0};
        u32x4 ov[2][4], gv[2][4];
#pragma unroll
        for (int q = 0; q < 2; ++q)
#pragma unroll
            for (int h = 0; h < 4; ++h) { ov[q][h] = *(const u32x4*)(O + (size_t)rows[q] * RET_V + h * 512 + 8 * lane); gv[q][h] = *(const u32x4*)(PROJ + (size_t)rows[q] * RET_IN + 4096 + h * 512 + 8 * lane); }
        float ss[2][4];
#pragma unroll
        for (int q = 0; q < 2; ++q)
#pragma unroll
            for (int h = 0; h < 4; ++h) { const float a0 = bf_lo(ov[q][h].x), a1 = bf_hi(ov[q][h].x), a2 = bf_lo(ov[q][h].y), a3 = bf_hi(ov[q][h].y), a4 = bf_lo(ov[q][h].z), a5 = bf_hi(ov[q][h].z), a6 = bf_lo(ov[q][h].w), a7 = bf_hi(ov[q][h].w);
                ss[q][h] = (a0 * a0 + a1 * a1) + (a2 * a2 + a3 * a3) + (a4 * a4 + a5 * a5) + (a6 * a6 + a7 * a7); }
#pragma unroll
        for (int o = 1; o < 64; o <<= 1) {
#pragma unroll
            for (int q = 0; q < 2; ++q)
#pragma unroll
                for (int h = 0; h < 4; ++h) ss[q][h] += __shfl_xor(ss[q][h], o); }
#pragma unroll
        for (int q = 0; q < 2; ++q) {
            if (q == 1 && !has1) break;
#pragma unroll
            for (int h = 0; h < 4; ++h) {
                const float rstd = rsqrtf(ss[q][h] * (1.f / 512.f) + EPS);
                const f32x4 g0 = gg[h][0], g1 = gg[h][1];
                const u32x4 o4 = ov[q][h], t4 = gv[q][h];
                const float y0 = bf_lo(o4.x) * rstd * g0.x * silu(bf_lo(t4.x)), y1 = bf_hi(o4.x) * rstd * g0.y * silu(bf_hi(t4.x));
                const float y2 = bf_lo(o4.y) * rstd * g0.z * silu(bf_lo(t4.y)), y3 = bf_hi(o4.y) * rstd * g0.w * silu(bf_hi(t4.y));
                const float y4 = bf_lo(o4.z) * rstd * g1.x * silu(bf_lo(t4.z)), y5 = bf_hi(o4.z) * rstd * g1.y * silu(bf_hi(t4.z));
                const float y6 = bf_lo(o4.w) * rstd * g1.z * silu(bf_lo(t4.w)), y7 = bf_hi(o4.w) * rstd * g1.w * silu(bf_hi(t4.w));
                u32x4 w; w.x = cvt_pk_bf16(y0, y1); w.y = cvt_pk_bf16(y2, y3); w.z = cvt_pk_bf16(y4, y5); w.w = cvt_pk_bf16(y6, y7);
                *(u32x4*)(OG + (size_t)rows[q] * RET_V + h * 512 + 8 * lane) = w;
            }
        }
    }
}

constexpr int AK_STRIDE = 144, AK_OFF = 0, AV_OFF = 36864;
__device__ __forceinline__ void swa_prompt_item(Ctx& F, int li, int item) {
    TIDS;
    const bf16_t* PROJ = (const bf16_t*)(F.ws + WS_PROJ); bf16_t* OG = (bf16_t*)(F.ws + WS_OG);
    const int b = item >> 6, n = (item >> 1) & 31, kvh = item & 1;
    const int g = wave, fr = lane & 15, fq = lane >> 4, q4 = fr >> 2, p4 = fr & 3;
    LAS unsigned char* KL = F.lds + AK_OFF; LAS unsigned char* VL = F.lds + AV_OFF;
    const float* qg = F.in[11] + li * 64; const float* kg = F.in[12] + li * 64;
    __syncthreads();
    {
        const int u = tid >> 1, hf = tid & 1;
        u32x4 kw[4], vw[4];
        if (n == 0 && u < 128) {
#pragma unroll
            for (int i = 0; i < 4; ++i) { kw[i] = (u32x4){0u, 0u, 0u, 0u}; vw[i] = (u32x4){0u, 0u, 0u, 0u}; }
        } else {
            const size_t tok = (size_t)b * SEQ + (n - 1) * 128 + u;
            const u32x4* kp = (const u32x4*)(PROJ + tok * SWA_IN + 1024 + kvh * 64 + 32 * hf);
            const u32x4* vp = (const u32x4*)(PROJ + tok * SWA_IN + 1152 + kvh * 64 + 32 * hf);
            float kf[32]; float ss = 0.f;
#pragma unroll
            for (int i = 0; i < 4; ++i) { const u32x4 k = kp[i]; vw[i] = vp[i];
                kf[8 * i + 0] = bf_lo(k.x); kf[8 * i + 1] = bf_hi(k.x); kf[8 * i + 2] = bf_lo(k.y); kf[8 * i + 3] = bf_hi(k.y);
                kf[8 * i + 4] = bf_lo(k.z); kf[8 * i + 5] = bf_hi(k.z); kf[8 * i + 6] = bf_lo(k.w); kf[8 * i + 7] = bf_hi(k.w); }
#pragma unroll
            for (int i = 0; i < 32; ++i) ss += kf[i] * kf[i];
            ss += __shfl_xor(ss, 1);
            const float rstd = rsqrtf(ss * (1.f / 64.f) + EPS);
#pragma unroll
            for (int i = 0; i < 32; ++i) kf[i] = kf[i] * rstd * kg[32 * hf + i];
#pragma unroll
            for (int i = 0; i < 4; ++i) { kw[i].x = cvt_pk_bf16(kf[8 * i], kf[8 * i + 1]); kw[i].y = cvt_pk_bf16(kf[8 * i + 2], kf[8 * i + 3]); kw[i].z = cvt_pk_bf16(kf[8 * i + 4], kf[8 * i + 5]); kw[i].w = cvt_pk_bf16(kf[8 * i + 6], kf[8 * i + 7]); }
            if (n == 31 && u >= 128) {
                float* ko = F.out + O_KP + (((size_t)(li * 4 + b) * 128 + (u - 128)) * 2 + kvh) * 64 + 32 * hf;
                float* vo = F.out + O_VP + (((size_t)(li * 4 + b) * 128 + (u - 128)) * 2 + kvh) * 64 + 32 * hf;
#pragma unroll
                for (int i = 0; i < 8; ++i) *(f32x4*)(ko + 4 * i) = (f32x4){kf[4 * i], kf[4 * i + 1], kf[4 * i + 2], kf[4 * i + 3]};
#pragma unroll
                for (int i = 0; i < 4; ++i) { *(f32x4*)(vo + 8 * i) = (f32x4){bf_lo(vw[i].x), bf_hi(vw[i].x), bf_lo(vw[i].y), bf_hi(vw[i].y)}; *(f32x4*)(vo + 8 * i + 4) = (f32x4){bf_lo(vw[i].z), bf_hi(vw[i].z), bf_lo(vw[i].w), bf_hi(vw[i].w)}; }
            }
        }
#pragma unroll
        for (int i = 0; i < 4; ++i) { *(LAS u32x4*)(KL + u * AK_STRIDE + 64 * hf + 16 * i) = kw[i]; *(LAS u32x4*)(VL + u * AK_STRIDE + 64 * hf + 16 * i) = vw[i]; }
    }
    __syncthreads();
    const int head = kvh * 8 + g;
    const float slope2 = exp2f(-0.5f * (float)(head + 1)) * LOG2E;
    const float sink2 = F.in[13][li * 16 + head] * LOG2E;
    float qg0[8], qg1[8];
#pragma unroll
    for (int i = 0; i < 8; ++i) { qg0[i] = qg[8 * fq + i] * (0.125f * LOG2E); qg1[i] = qg[32 + 8 * fq + i] * (0.125f * LOG2E); }
    u32x4 nq0, nq1; u32x2 ngr[4];
    {   const size_t tokn = (size_t)b * SEQ + n * 128 + fr;
        nq0 = *(const u32x4*)(PROJ + tokn * SWA_IN + head * 64 + 8 * fq); nq1 = *(const u32x4*)(PROJ + tokn * SWA_IN + head * 64 + 32 + 8 * fq);
#pragma unroll
        for (int d = 0; d < 4; ++d) ngr[d] = *(const u32x2*)(PROJ + tokn * SWA_IN + 1280 + head * 64 + 16 * d + 4 * fq); }
#pragma unroll 1
    for (int tf = 0; tf < 8; ++tf) {
        const int j = 16 * tf + fr;
        const size_t tok = (size_t)b * SEQ + n * 128 + j;
        bf16x8 qf[2];
        const u32x4 r0 = nq0, r1 = nq1; u32x2 gcur[4];
#pragma unroll
        for (int d = 0; d < 4; ++d) gcur[d] = ngr[d];
        {   const size_t tokn = tok + (tf < 7 ? 16 : 0);
            nq0 = *(const u32x4*)(PROJ + tokn * SWA_IN + head * 64 + 8 * fq); nq1 = *(const u32x4*)(PROJ + tokn * SWA_IN + head * 64 + 32 + 8 * fq);
#pragma unroll
            for (int d = 0; d < 4; ++d) ngr[d] = *(const u32x2*)(PROJ + tokn * SWA_IN + 1280 + head * 64 + 16 * d + 4 * fq); }
        {
            float q0[8] = {bf_lo(r0.x), bf_hi(r0.x), bf_lo(r0.y), bf_hi(r0.y), bf_lo(r0.z), bf_hi(r0.z), bf_lo(r0.w), bf_hi(r0.w)};
            float q1[8] = {bf_lo(r1.x), bf_hi(r1.x), bf_lo(r1.y), bf_hi(r1.y), bf_lo(r1.z), bf_hi(r1.z), bf_lo(r1.w), bf_hi(r1.w)};
            float ss = 0.f;
#pragma unroll
            for (int i = 0; i < 8; ++i) ss += q0[i] * q0[i] + q1[i] * q1[i];
            ss += __shfl_xor(ss, 16); ss += __shfl_xor(ss, 32);
            const float sc = rsqrtf(ss * (1.f / 64.f) + EPS);
#pragma unroll
            for (int i = 0; i < 8; ++i) { q0[i] *= sc * qg0[i]; q1[i] *= sc * qg1[i]; }
            qf[0] = pack8(q0[0], q0[1], q0[2], q0[3], q0[4], q0[5], q0[6], q0[7]);
            qf[1] = pack8(q1[0], q1[1], q1[2], q1[3], q1[4], q1[5], q1[6], q1[7]);
        }
        const int f0 = tf < 6 ? tf : 6;
        f32x4 sc[10];
#pragma unroll
        for (int f = 0; f < 10; ++f) {
            sc[f] = (f32x4){0.f, 0.f, 0.f, 0.f};
#pragma unroll
            for (int ks = 0; ks < 2; ++ks) { const bf16x8 kf = *(const LAS bf16x8*)(KL + (16 * (f0 + f) + fr) * AK_STRIDE + (32 * ks + 8 * fq) * 2); sc[f] = MFMA16(kf, qf[ks], sc[f]); }
        }
        float mx = sink2;
#pragma unroll
        for (int f = 0; f < 10; ++f)
#pragma unroll
            for (int r = 0; r < 4; ++r) { const int u = 16 * (f0 + f) + 4 * fq + r; const int dist = 128 + j - u;
                const bool valid = (dist >= 0) && (dist <= 128) && (n > 0 || u >= 128);
                const float s = valid ? sc[f][r] - slope2 * (float)dist : -1e30f; sc[f][r] = s; mx = fmaxf(mx, s); }
        mx = fmaxf(mx, __shfl_xor(mx, 16)); mx = fmaxf(mx, __shfl_xor(mx, 32));
        float l = 0.f;
#pragma unroll
        for (int f = 0; f < 10; ++f)
#pragma unroll
            for (int r = 0; r < 4; ++r) { const float p = __builtin_amdgcn_exp2f(sc[f][r] - mx); sc[f][r] = p; l += p; }
        l += __shfl_xor(l, 16); l += __shfl_xor(l, 32);
        l += __builtin_amdgcn_exp2f(sink2 - mx);
        const float inv = 1.f / l;
        f32x4 oa[4];
#pragma unroll
        for (int d = 0; d < 4; ++d) oa[d] = (f32x4){0.f, 0.f, 0.f, 0.f};
#pragma unroll
        for (int kk = 0; kk < 5; ++kk) {
            const bf16x8 pf = pack8(sc[2 * kk][0], sc[2 * kk][1], sc[2 * kk][2], sc[2 * kk][3], sc[2 * kk + 1][0], sc[2 * kk + 1][1], sc[2 * kk + 1][2], sc[2 * kk + 1][3]);
#pragma unroll
            for (int d = 0; d < 4; ++d) {
                const LAS unsigned char* a0 = VL + (16 * (f0 + 2 * kk) + 4 * fq + q4) * AK_STRIDE + (16 * d + 4 * p4) * 2;
                const bf16x8 vf = cat8(tr_read(a0), tr_read(a0 + 16 * AK_STRIDE));
                oa[d] = MFMA16(vf, pf, oa[d]);
            }
        }
#pragma unroll
        for (int d = 0; d < 4; ++d) {
            const u32x2 gr = gcur[d];
            const float y0 = oa[d][0] * inv * silu(bf_lo(gr.x)), y1 = oa[d][1] * inv * silu(bf_hi(gr.x)), y2 = oa[d][2] * inv * silu(bf_lo(gr.y)), y3 = oa[d][3] * inv * silu(bf_hi(gr.y));
            u32x2 ow; ow.x = cvt_pk_bf16(y0, y1); ow.y = cvt_pk_bf16(y2, y3);
            *(u32x2*)(OG + tok * D + head * 64 + 16 * d + 4 * fq) = ow;
        }
    }
}
__device__ __forceinline__ void swa_sample_item(Ctx& F, int li, int item) {
    TIDS;
    const bf16_t* PROJ = (const bf16_t*)(F.ws + WS_PROJ); bf16_t* OG = (bf16_t*)(F.ws + WS_OG);
    const int b = item >> 1, kvh = item & 1, g = wave;
    LAS float* Kf = (LAS float*)F.lds;
    LAS float* Vf = Kf + 8400;
    LAS float* pb = Vf + 129 * 64;
    LAS float* qb = pb + 8 * 136;
    const bf16_t* row = PROJ + (size_t)(MP + b) * SWA_IN;
    __syncthreads();
    {
        const int u = tid >> 2, dq = tid & 3;
        const size_t ci = (((size_t)(li * 128 + b) * 128 + u) * 2 + kvh) * 64 + 16 * dq;
        const float* kc = F.in[3] + ci; const float* vc = F.in[4] + ci;
#pragma unroll
        for (int i = 0; i < 4; ++i) {
            const f32x4 k = *(const f32x4*)(kc + 4 * i), v = *(const f32x4*)(vc + 4 * i);
            Kf[u * 65 + 16 * dq + 4 * i + 0] = k.x; Kf[u * 65 + 16 * dq + 4 * i + 1] = k.y; Kf[u * 65 + 16 * dq + 4 * i + 2] = k.z; Kf[u * 65 + 16 * dq + 4 * i + 3] = k.w;
            *(LAS f32x4*)(Vf + u * 64 + 16 * dq + 4 * i) = v;
            if (u >= 1) { const size_t oi = (((size_t)(li * 128 + b) * 128 + (u - 1)) * 2 + kvh) * 64 + 16 * dq + 4 * i; *(f32x4*)(F.out + O_KS + oi) = k; *(f32x4*)(F.out + O_VS + oi) = v; }
        }
    }
    if (g == 0) {
        const float k = bf2f(row[1024 + kvh * 64 + lane]);
        const float kn = k * rsqrtf(wave_sum(k * k) * (1.f / 64.f) + EPS) * F.in[12][li * 64 + lane];
        Kf[128 * 65 + lane] = kn;
        F.out[O_KS + (((size_t)(li * 128 + b) * 128 + 127) * 2 + kvh) * 64 + lane] = kn;
    } else if (g == 1) {
        const float v = bf2f(row[1152 + kvh * 64 + lane]);
        Vf[128 * 64 + lane] = v;
        F.out[O_VS + (((size_t)(li * 128 + b) * 128 + 127) * 2 + kvh) * 64 + lane] = v;
    }
    const int head = kvh * 8 + g;
    {
        const float q = bf2f(row[head * 64 + lane]);
        qb[g * 64 + lane] = q * rsqrtf(wave_sum(q * q) * (1.f / 64.f) + EPS) * F.in[11][li * 64 + lane] * 0.125f;
    }
    __syncthreads();
    const float slope = exp2f(-0.5f * (float)(head + 1));
    const float sink = F.in[13][li * 16 + head];
    float s0 = 0.f, s1 = 0.f, s2 = 0.f;
#pragma unroll 8
    for (int d = 0; d < 64; ++d) { const float q = qb[g * 64 + d]; s0 += q * Kf[lane * 65 + d]; s1 += q * Kf[(lane + 64) * 65 + d]; s2 += q * Kf[128 * 65 + d]; }
    s0 -= slope * (float)(128 - lane); s1 -= slope * (float)(64 - lane);
    const float mx = fmaxf(fmaxf(wave_max(fmaxf(s0, s1)), s2), sink);
    const float e0 = __expf(s0 - mx), e1 = __expf(s1 - mx), e2 = __expf(s2 - mx);
    const float l = wave_sum(e0 + e1) + e2 + __expf(sink - mx);
    pb[g * 136 + lane] = e0; pb[g * 136 + 64 + lane] = e1; if (lane == 0) pb[g * 136 + 128] = e2;
    __syncthreads();
    float o = 0.f;
#pragma unroll 8
    for (int u = 0; u < 129; ++u) o += pb[g * 136 + u] * Vf[u * 64 + lane];
    o = o / l * silu(bf2f(row[1280 + head * 64 + lane]));
    OG[(size_t)(MP + b) * D + head * 64 + lane] = (bf16_t)(cvt_pk_bf16(o, 0.f) & 0xffffu);
}

__global__ void __launch_bounds__(512, 2) hybrid_fwd(Args args) {
    extern __shared__ __attribute__((aligned(16))) unsigned char lds_raw[];
    cg::grid_group grid = cg::this_grid();
    Ctx F;
    F.lds = (LAS unsigned char*)lds_raw;
    F.G = gridDim.x; F.bid = blockIdx.x; F.vcu = (F.G % 8 == 0) ? (F.bid % 8) * (F.G / 8) + F.bid / 8 : F.bid;
#pragma unroll
    for (int i = 0; i < 15; ++i) F.in[i] = args.in[i];
    F.out = args.out; F.ws = args.ws;
    bf16_t* H = (bf16_t*)(F.ws + WS_H); bf16_t* PROJ = (bf16_t*)(F.ws + WS_PROJ); bf16_t* OG = (bf16_t*)(F.ws + WS_OG);
    volatile LAS unsigned* MISC = (volatile LAS unsigned*)(F.lds + MISC_OFF);
    if (threadIdx.x < 16) MISC[threadIdx.x] = 0u;
    if (blockIdx.x == 0) { unsigned* bw = (unsigned*)(F.ws + WS_BAR); for (int i = threadIdx.x; i < 4096; i += 512) __hip_atomic_store(bw + i, 0u, __ATOMIC_RELAXED, __HIP_MEMORY_SCOPE_AGENT); }
    __syncthreads();
#define GRID_BAR() xcd_barrier(bar)
    float* yp = F.out + O_YP; float* ys = F.out + O_YS;

    phase_weights(F, 0, W_FIRST, F.bid * 8, F.G * 8);
    phase_norm(F, F.in[0], F.in[1], F.in[5]);
    grid.sync();
    const XcdBarrier bar = xcd_barrier_post((unsigned*)(F.ws + WS_BAR), MISC + 8);

#pragma unroll 1
    for (int layer = 0; layer < 4; ++layer) {
        const int li = layer >> 1;
        const float* xp = layer == 0 ? F.in[0] : yp; const float* xs = layer == 0 ? F.in[1] : ys;
        if ((layer & 1) == 0) {
            const bf16_t* Wi = (const bf16_t*)(F.ws + WS_WIN_RET) + (size_t)li * RET_IN * D; const bf16_t* Wo = (const bf16_t*)(F.ws + WS_WOUT_RET) + (size_t)li * D * RET_V;
            {
                pg8::Gemm g{H, Wi, MP, RET_IN, D}; pg8::StaticOrder S; S.init(MP, RET_IN, F.G, F.bid);
                pg8::EpiProjRet E{(bf16_t*)(F.ws + WS_QB), (bf16_t*)(F.ws + WS_KB), (bf16_t*)(F.ws + WS_VB), PROJ, RET_IN};
                pg8::gemm_phase<pg8::EpiProjRet, pg8::StaticOrder, false, true>(F.lds, g, S, E);
                small_gemm<D, 4>(F, H + (size_t)MP * D, Wi, RET_IN, [&](int r, int c, f32x4 v) {
                    if (c >= 1024 && c < 2048) v *= 0.0625f;
                    u32x2 o; o.x = cvt_pk_bf16(v[0], v[1]); o.y = cvt_pk_bf16(v[2], v[3]); *(u32x2*)(PROJ + (size_t)(MP + r) * RET_IN + c) = o; });
            }
            GRID_BAR();
            {
                const bool x8 = (F.G % 16 == 0); const int L = x8 ? F.G / 8 : F.G, x = x8 ? F.bid % 8 : 0, j = x8 ? F.bid / 8 : F.bid, hl = L / 2;
                const int nscan = x8 ? F.G / 2 : hl, nstream = x8 ? F.G / 2 : L - hl;
                if (j < hl) { for (int it = x * hl + j; it < 128; it += nscan) ret_scan_item(F, li, it); }
                else { for (int it = x * hl + (j - hl); it < 512; it += nstream) ret_sample_item(F, li, it);
                       if (layer == 0) { __syncthreads(); phase_weights(F, W_FIRST, W_ALL, (x * hl + (j - hl)) * 8, nstream * 8); } }
            }
            GRID_BAR();
            phase_ret_gate(F, li);
            GRID_BAR();
            {
                pg8::Gemm g{OG, Wo, MP, D, RET_V}; pg8::StaticOrder S; S.init(MP, D, F.G, F.bid);
                pg8::EpiRes E{xp, yp, D};
                pg8::gemm_phase<pg8::EpiRes, pg8::StaticOrder, true, true>(F.lds, g, S, E);
                small_gemm<RET_V, 2>(F, OG + (size_t)MP * RET_V, Wo, D, [&](int r, int c, f32x4 v) {
                    const f32x4 x = *(const f32x4*)(xs + (size_t)r * D + c); *(f32x4*)(ys + (size_t)r * D + c) = x + v; });
            }
            GRID_BAR();
        } else {
            const bf16_t* Wi = (const bf16_t*)(F.ws + WS_WIN_SWA) + (size_t)li * SWA_IN * D; const bf16_t* Wo = (const bf16_t*)(F.ws + WS_WOUT_SWA) + (size_t)li * D * D;
            {
                pg8::Gemm g{H, Wi, MP, SWA_IN, D}; pg8::StaticOrder S; S.init(MP, SWA_IN, F.G, F.bid);
                pg8::EpiProj E{PROJ, SWA_IN, 0, 0, 1.f};
                pg8::gemm_phase<pg8::EpiProj, pg8::StaticOrder, false, true>(F.lds, g, S, E);
                small_gemm<D, 4>(F, H + (size_t)MP * D, Wi, SWA_IN, [&](int r, int c, f32x4 v) {
                    u32x2 o; o.x = cvt_pk_bf16(v[0], v[1]); o.y = cvt_pk_bf16(v[2], v[3]); *(u32x2*)(PROJ + (size_t)(MP + r) * SWA_IN + c) = o; });
            }
            GRID_BAR();
            for (int it = F.vcu; it < 256; it += F.G) swa_prompt_item(F, li, it);
            for (int it = F.bid; it < 256; it += F.G) swa_sample_item(F, li, it);
            GRID_BAR();
            {
                pg8::Gemm g{OG, Wo, MP, D, D}; pg8::StaticOrder S; S.init(MP, D, F.G, F.bid);
                pg8::EpiRes E{xp, yp, D};
                pg8::gemm_phase<pg8::EpiRes, pg8::StaticOrder, true, true>(F.lds, g, S, E);
                small_gemm<D, 2>(F, OG + (size_t)MP * D, Wo, D, [&](int r, int c, f32x4 v) {
                    const f32x4 x = *(const f32x4*)(xs + (size_t)r * D + c); *(f32x4*)(ys + (size_t)r * D + c) = x + v; });
            }
            GRID_BAR();
        }
        if (layer < 3) {
            const float* gnext = ((layer + 1) & 1) ? F.in[9] + (size_t)((layer + 1) >> 1) * D : F.in[5] + (size_t)((layer + 1) >> 1) * D;
            phase_norm(F, yp, ys, gnext);
            GRID_BAR();
        }
    }
}

extern "C" void kernel_launch(void* const* d_in, const int* in_sizes, int n_in, void* d_out, int out_size, void* d_ws, size_t ws_size, hipStream_t stream) {
    static int grid = 0;
    if (grid == 0) {
        if (n_in != 15 || (size_t)out_size != O_END || ws_size < WS_END) { fprintf(stderr, "kernel_launch: unexpected shapes (n_in %d out %d ws %zu)\n", n_in, out_size, ws_size); grid = -1; return; }
        int dev = 0, cus = 0, per_cu = 0;
        if (hipGetDevice(&dev) != hipSuccess || hipDeviceGetAttribute(&cus, hipDeviceAttributeMultiprocessorCount, dev) != hipSuccess) { grid = -1; return; }
        if (hipFuncSetAttribute((const void*)hybrid_fwd, hipFuncAttributeMaxDynamicSharedMemorySize, LDS_BYTES) != hipSuccess) { fprintf(stderr, "kernel_launch: hipFuncSetAttribute failed\n"); grid = -1; return; }
        if (hipOccupancyMaxActiveBlocksPerMultiprocessor(&per_cu, (const void*)hybrid_fwd, 512, LDS_BYTES) != hipSuccess || per_cu < 1) { fprintf(stderr, "kernel_launch: occupancy query failed (%d)\n", per_cu); (void)hipGetLastError(); per_cu = 1; }
        grid = cus * per_cu;
    }
    if (grid < 0) return;
    Args a{};
    for (int i = 0; i < 15; ++i) a.in[i] = (const float*)d_in[i];
    a.out = (float*)d_out; a.ws = (unsigned char*)d_ws;
    void* kargs[] = {&a};
    hipError_t e = hipLaunchCooperativeKernel((const void*)hybrid_fwd, dim3(grid), dim3(512), kargs, LDS_BYTES, stream);
    if (e != hipSuccess) fprintf(stderr, "kernel_launch: cooperative launch failed: %s (grid %d)\n", hipGetErrorString(e), grid);
}
```

```cpp
#include <hip/hip_runtime.h>
#include <hip/hip_cooperative_groups.h>
#include <cstdio>
#include <cstdint>
namespace cg = cooperative_groups;

#define LAS __attribute__((address_space(3)))
typedef unsigned short bf16_t;
typedef short bf16x8 __attribute__((ext_vector_type(8)));
typedef short s16x4 __attribute__((ext_vector_type(4)));
typedef float f32x4 __attribute__((ext_vector_type(4)));
typedef float f32x2 __attribute__((ext_vector_type(2)));
typedef unsigned u32x4 __attribute__((ext_vector_type(4)));
typedef unsigned u32x2 __attribute__((ext_vector_type(2)));

constexpr int D = 1024, MP = 16384, MS = 128, MT = 16640, SEQ = 4096;
constexpr int RET_IN = 6144, SWA_IN = 2304, RET_V = 2048;
constexpr float EPS = 1e-6f;
constexpr float LOG2E = 1.4426950408889634f;

constexpr size_t O_YP = 0, O_YS = 16777216, O_RETP = 16908288, O_RETS = 21102592, O_KP = 155320320, O_VP = 155451392, O_KS = 155582464, O_VS = 159776768, O_END = 163971072;

constexpr size_t MiB = 1u << 20;
constexpr size_t WS_WIN_RET = 0, WS_WOUT_RET = 24 * MiB, WS_WIN_SWA = 32 * MiB, WS_WOUT_SWA = 41 * MiB, WS_H = 48 * MiB, WS_PROJ = 96 * MiB,
                 WS_P = 292 * MiB, WS_O = 308 * MiB, WS_OG = 376 * MiB, WS_BAR = 447 * MiB,
                 WS_QB = 448 * MiB  , WS_KB = 480 * MiB  , WS_VB = 512 * MiB  , WS_END = 576 * MiB;
constexpr int LDS_BYTES = 163840, MISC_OFF = 163840 - 256;

__device__ __forceinline__ unsigned cvt_pk_bf16(float lo, float hi) { unsigned r; asm volatile("v_cvt_pk_bf16_f32 %0, %1, %2" : "=v"(r) : "v"(lo), "v"(hi)); return r; }
__device__ __forceinline__ float bf_lo(unsigned u) { return __builtin_bit_cast(float, u << 16); }
__device__ __forceinline__ float bf_hi(unsigned u) { return __builtin_bit_cast(float, u & 0xffff0000u); }
__device__ __forceinline__ float bf2f(bf16_t b) { return __builtin_bit_cast(float, ((unsigned)b) << 16); }
__device__ __forceinline__ float wave_sum(float v) {
#pragma unroll
    for (int o = 1; o < 64; o <<= 1) v += __shfl_xor(v, o);
    return v;
}
__device__ __forceinline__ float wave_max(float v) {
#pragma unroll
    for (int o = 1; o < 64; o <<= 1) v = fmaxf(v, __shfl_xor(v, o));
    return v;
}
__device__ __forceinline__ float silu(float x) { return x / (1.f + __expf(-x)); }
__device__ __forceinline__ s16x4 tr_read(const LAS unsigned char* p) {
    typedef short v4i16_t __attribute__((ext_vector_type(4)));
    return __builtin_bit_cast(s16x4, __builtin_amdgcn_ds_read_tr16_b64_v4i16((LAS v4i16_t*)p));
}
__device__ __forceinline__ bf16x8 cat8(s16x4 a, s16x4 b) { bf16x8 r; r[0] = a[0]; r[1] = a[1]; r[2] = a[2]; r[3] = a[3]; r[4] = b[0]; r[5] = b[1]; r[6] = b[2]; r[7] = b[3]; return r; }
__device__ __forceinline__ bf16x8 pack8(float a0, float a1, float a2, float a3, float a4, float a5, float a6, float a7) {
    u32x4 w; w.x = cvt_pk_bf16(a0, a1); w.y = cvt_pk_bf16(a2, a3); w.z = cvt_pk_bf16(a4, a5); w.w = cvt_pk_bf16(a6, a7); return __builtin_bit_cast(bf16x8, w);
}
#define LDS_BARRIER() do { asm volatile("s_waitcnt lgkmcnt(0)" ::: "memory"); __builtin_amdgcn_s_barrier(); asm volatile("" ::: "memory"); } while (0)
#define MFMA16(a, b, c) __builtin_amdgcn_mfma_f32_16x16x32_bf16((a), (b), (c), 0, 0, 0)

namespace pg8 {
#define PG8_LAS __attribute__((address_space(3)))
constexpr int BM = 256, BK = 64, HALF = 128, HTB = HALF * BK * 2, STAGE_BYTES = 8 * HTB, NXCD = 8, WGM = 8;
__host__ __device__ __forceinline__ int lds_byte(int r, int c) { const int st = (r >> 4) * 2 + (c >> 5), rr = r & 15, cc = c & 31, ob = rr * 64 + cc * 2; return st * 1024 + (ob ^ (((ob >> 9) & 1) << 5)); }
__host__ __device__ __forceinline__ void stage_rc(int b, int& R, int& C) { const int st = b / 1024, sb = b % 1024, swz = sb ^ (((sb >> 9) & 1) << 5); R = (st >> 1) * 16 + swz / 64; C = (st & 1) * 32 + (swz % 64) / 2; }
__host__ __device__ __forceinline__ int perm32(int rho) { const int n = rho >> 4, i = rho & 15; return 8 * (i >> 2) + 4 * n + (i & 3); }
struct Unit { int pm, pn; };
struct Gemm { const bf16_t* A; const bf16_t* Bt; int M, N, K; };
struct StaticOrder {
    int nM, nN, nwg, G, c;
    __host__ __device__ void init(int M, int N, int G_, int c_) { nM = M / BM; nN = N / BM; nwg = nM * nN; G = G_; c = c_; }
    __host__ __device__ bool next(int i, Unit& u) const {
        const long L = (long)i * G + c; if (L >= nwg) return false;
        int wgid = (int)L; { const int q = nwg / NXCD, r = nwg % NXCD, xcd = wgid % NXCD, off = wgid / NXCD; wgid = (xcd < r ? xcd * (q + 1) : r * (q + 1) + (xcd - r) * q) + off; }
        const int nig = WGM * nN, gid = wgid / nig, fm = gid * WGM, gsz = (nM - fm) < WGM ? (nM - fm) : WGM;
        u.pm = fm + ((wgid % nig) % gsz); u.pn = (wgid % nig) / gsz; return true;
    }
    __device__ __forceinline__ void a_ready(const Unit&) const {}
    __device__ __forceinline__ void done(const Unit&) const {}
};
struct EpiProj {
    static constexpr bool PERM = true;
    bf16_t* O; int ldc; int sc_lo, sc_hi; float scale;
    __device__ __forceinline__ void operator()(const f32x4 (&acc)[2][2][4][2], const Unit& u, int wr, int wc, int fr, int fq) const {
        const int row0 = u.pm * BM + wr * 64 + fr; const int col0 = u.pn * BM + wc * 32 + 8 * fq;
        const float sc = (u.pn >= sc_lo && u.pn < sc_hi) ? scale : 1.f;
#pragma unroll
        for (int ai = 0; ai < 2; ++ai)
#pragma unroll
            for (int m = 0; m < 4; ++m) { bf16_t* rowp = O + (size_t)(row0 + ai * HALF + m * 16) * ldc + col0;
#pragma unroll
                for (int bj = 0; bj < 2; ++bj) { f32x4 v0 = acc[ai][bj][m][0] * sc, v1 = acc[ai][bj][m][1] * sc;
                    u32x4 w; w.x = cvt_pk_bf16(v0[0], v0[1]); w.y = cvt_pk_bf16(v0[2], v0[3]); w.z = cvt_pk_bf16(v1[0], v1[1]); w.w = cvt_pk_bf16(v1[2], v1[3]);
                    *(u32x4*)(rowp + bj * HALF) = w; } }
    }
};
struct EpiProjRet {
    static constexpr bool PERM = true;
    bf16_t* QB; bf16_t* KB; bf16_t* VB; bf16_t* G; int ldg;
    __device__ __forceinline__ void operator()(const f32x4 (&acc)[2][2][4][2], const Unit& u, int wr, int wc, int fr, int fq) const {
        const int pn = u.pn, t0 = wr * 64 + fr; const size_t tile0 = (size_t)((u.pm >> 4) * 32 + ((u.pm & 15) << 1)) * 4;
        const float sc = (pn >= 4 && pn < 8) ? 0.0625f : 1.f;
        bf16_t* base; size_t sa; int sm, sbj;
        if (pn < 8) { base = (pn < 4 ? QB : KB) + (tile0 + (pn & 3)) * 32768 + t0 * 256 + wc * 32 + 8 * fq; sa = 4 * 32768; sm = 16 * 256; sbj = HALF; }
        else if (pn < 16) { base = VB + ((tile0 + ((pn - 8) >> 1)) * 8 + (pn & 1) * 4 + (wc >> 1)) * 8192 + t0 * 64 + 32 * (wc & 1) + 8 * fq; sa = 4 * 8 * 8192; sm = 16 * 64; sbj = 2 * 8192; }
        else { base = G + (size_t)(u.pm * BM + t0) * ldg + pn * BM + wc * 32 + 8 * fq; sa = (size_t)HALF * ldg; sm = 16 * ldg; sbj = HALF; }
#pragma unroll
        for (int ai = 0; ai < 2; ++ai)
#pragma unroll
            for (int m = 0; m < 4; ++m) { bf16_t* rowp = base + ai * sa + (size_t)m * sm;
#pragma unroll
                for (int bj = 0; bj < 2; ++bj) { f32x4 v0 = acc[ai][bj][m][0] * sc, v1 = acc[ai][bj][m][1] * sc;
                    u32x4 w; w.x = cvt_pk_bf16(v0[0], v0[1]); w.y = cvt_pk_bf16(v0[2], v0[3]); w.z = cvt_pk_bf16(v1[0], v1[1]); w.w = cvt_pk_bf16(v1[2], v1[3]);
                    *(u32x4*)(rowp + bj * sbj) = w; } }
    }
};
struct EpiRes {
    static constexpr bool PERM = false;
    const float* X; float* Y; int ldc;
    __device__ __forceinline__ void operator()(const f32x4 (&acc)[2][2][4][2], const Unit& u, int wr, int wc, int fr, int fq) const {
        const int row0 = u.pm * BM + wr * 64 + fr, col0 = u.pn * BM + wc * 32 + 4 * fq;
#pragma unroll
        for (int ai = 0; ai < 2; ++ai)
#pragma unroll
            for (int m = 0; m < 4; ++m) { const size_t ro = (size_t)(row0 + ai * HALF + m * 16) * ldc + col0;
#pragma unroll
                for (int bj = 0; bj < 2; ++bj)
#pragma unroll
                    for (int n = 0; n < 2; ++n) { const size_t ix = ro + bj * HALF + n * 16; const f32x4 x = *(const f32x4*)(X + ix); *(f32x4*)(Y + ix) = x + acc[ai][bj][m][n]; } }
    }
};

template <class Epi, class Sched, bool ALIGN_EPI = false, bool SP2 = false>
__device__ __forceinline__ void gemm_phase(PG8_LAS unsigned char* lds, const Gemm g, const Sched& S, const Epi& E) {
    int tid = threadIdx.x; asm volatile("" : "+v"(tid));
    const int wid = __builtin_amdgcn_readfirstlane(tid >> 6), lane = tid & 63, wr = wid >> 2, wc = wid & 3, fr = lane & 15, fq = lane >> 4;
    const int K = g.K, nt = K / BK;
    unsigned voffA[2], voffB[2];
#pragma unroll
    for (int i = 0; i < 2; ++i) { int R, C; stage_rc(tid * 16 + i * 8192, R, C); const int Rb = Epi::PERM ? ((R & ~31) + perm32(R & 31)) : R;
        voffA[i] = (unsigned)(R * K + C) * 2u; voffB[i] = (unsigned)(Rb * K + C) * 2u; }
    const size_t kstep = (size_t)(BK * 2);
    const size_t hstep = (size_t)HALF * K * 2;
    const size_t tstep = 2 * hstep;
    const unsigned ldsw = (unsigned)wid * 1024u;
    const int aoff = lds_byte(wr * 64 + fr, fq * 8), boff = lds_byte(wc * 32 + fr, fq * 8);
#define PG8_SA(b, h) (((b) * 2 + (h)) * HTB)
#define PG8_SB(b, h) ((4 + (b) * 2 + (h)) * HTB)
#define PG8_STAGE(bufoff, gbase, voff) do { _Pragma("unroll") for (int _i = 0; _i < 2; ++_i) \
        __builtin_amdgcn_global_load_lds((const unsigned*)((const char*)(gbase) + (voff)[_i]), (PG8_LAS unsigned*)(lds + (bufoff) + ldsw + _i * 8192), 16, 0, 0); } while (0)
#define PG8_LDA(dst, b, h) do { _Pragma("unroll") for (int m = 0; m < 4; ++m) _Pragma("unroll") for (int k = 0; k < 2; ++k) dst[m][k] = *(const PG8_LAS bf16x8*)(lds + PG8_SA(b, h) + aoff + m * 2048 + k * 1024); } while (0)
#define PG8_LDB(dst, b, h) do { _Pragma("unroll") for (int n = 0; n < 2; ++n) _Pragma("unroll") for (int k = 0; k < 2; ++k) dst[n][k] = *(const PG8_LAS bf16x8*)(lds + PG8_SB(b, h) + boff + n * 2048 + k * 1024); } while (0)
#define PG8_MMA(ai, bj, At, Bt) do { __builtin_amdgcn_s_setprio(1); _Pragma("unroll") for (int m = 0; m < 4; ++m) _Pragma("unroll") for (int n = 0; n < 2; ++n) _Pragma("unroll") for (int k = 0; k < 2; ++k) \
        acc[ai][bj][m][n] = __builtin_amdgcn_mfma_f32_16x16x32_bf16(Bt[n][k], At[m][k], acc[ai][bj][m][n], 0, 0, 0); __builtin_amdgcn_s_setprio(0); } while (0)
#define PG8_WAIT_V(n) asm volatile("s_waitcnt vmcnt(" #n ")" ::: "memory")
#define PG8_WAIT_L(n) asm volatile("s_waitcnt lgkmcnt(" #n ")" ::: "memory")
#define PG8_BAR __builtin_amdgcn_s_barrier()
#define PG8_SCHED __builtin_amdgcn_sched_barrier(0)
    Unit cur, nxt; int ui = 0;
    if (!S.next(0, cur)) return;
    f32x4 acc[2][2][4][2];
#pragma unroll
    for (int a = 0; a < 2; ++a)
#pragma unroll
        for (int b = 0; b < 2; ++b)
#pragma unroll
            for (int m = 0; m < 4; ++m)
#pragma unroll
                for (int n = 0; n < 2; ++n) acc[a][b][m][n] = (f32x4){0.f, 0.f, 0.f, 0.f};
    bf16x8 At[4][2], B0[2][2], B1[2][2];
    const char* cA = (const char*)g.A + (size_t)cur.pm * tstep; const char* cB = (const char*)g.Bt + (size_t)cur.pn * tstep;
    S.a_ready(cur);
    if constexpr (SP2) {
        PG8_STAGE(PG8_SB(0, 0), cB, voffB); PG8_STAGE(PG8_SB(0, 1), cB + hstep, voffB); PG8_STAGE(PG8_SA(0, 0), cA, voffA); PG8_STAGE(PG8_SA(0, 1), cA + hstep, voffA);
        if (wr == 1) PG8_BAR;
        PG8_WAIT_V(2); PG8_BAR;
        PG8_STAGE(PG8_SB(1, 0), cB + kstep, voffB); PG8_STAGE(PG8_SA(1, 0), cA + kstep, voffA); PG8_STAGE(PG8_SB(1, 1), cB + hstep + kstep, voffB);
        PG8_WAIT_V(6); PG8_BAR;
    } else {
        PG8_STAGE(PG8_SB(0, 0), cB, voffB); PG8_STAGE(PG8_SA(0, 0), cA, voffA); PG8_STAGE(PG8_SB(0, 1), cB + hstep, voffB); PG8_STAGE(PG8_SA(0, 1), cA + hstep, voffA);
        if (wr == 1) PG8_BAR;
        PG8_WAIT_V(4); PG8_BAR;
        PG8_STAGE(PG8_SB(1, 0), cB + kstep, voffB); PG8_STAGE(PG8_SA(1, 0), cA + kstep, voffA); PG8_STAGE(PG8_SB(1, 1), cB + hstep + kstep, voffB);
        PG8_WAIT_V(6); PG8_BAR;
    }
    for (;;) {
        const bool has_next = S.next(ui + 1, nxt);
        const char* nA = has_next ? (const char*)g.A + (size_t)nxt.pm * tstep : cA; const char* nB = has_next ? (const char*)g.Bt + (size_t)nxt.pn * tstep : cB;
        for (int t = 0; t < nt; t += 2) {
            const bool last = (t == nt - 2);
            const char* a1 = cA + (size_t)(t + 1) * kstep;
            const char* a2 = last ? nA : cA + (size_t)(t + 2) * kstep; const char* b2 = last ? nB : cB + (size_t)(t + 2) * kstep;
            const char* a3 = a2 + kstep; const char* b3 = b2 + kstep;
            if (last && has_next) S.a_ready(nxt);
            if constexpr (SP2) {
            PG8_LDB(B0, 0, 0); PG8_LDB(B1, 0, 1); PG8_SCHED; PG8_LDA(At, 0, 0); PG8_STAGE(PG8_SA(1, 1), a1 + hstep, voffA);
            PG8_WAIT_V(8); PG8_WAIT_L(0); PG8_BAR; PG8_MMA(0, 0, At, B0); PG8_MMA(0, 1, At, B1); PG8_BAR; PG8_SCHED;
            PG8_LDA(At, 0, 1); PG8_STAGE(PG8_SB(0, 0), b2, voffB); PG8_STAGE(PG8_SB(0, 1), b2 + hstep, voffB); PG8_STAGE(PG8_SA(0, 0), a2, voffA);
            PG8_WAIT_V(8); PG8_WAIT_L(0); PG8_BAR; PG8_MMA(1, 0, At, B0); PG8_MMA(1, 1, At, B1); PG8_BAR; PG8_SCHED;
            PG8_LDB(B0, 1, 0); PG8_LDB(B1, 1, 1); PG8_SCHED; PG8_LDA(At, 1, 0); PG8_STAGE(PG8_SA(0, 1), a2 + hstep, voffA);
            PG8_WAIT_V(8); PG8_WAIT_L(0); PG8_BAR; PG8_MMA(0, 0, At, B0); PG8_MMA(0, 1, At, B1); PG8_BAR; PG8_SCHED;
            PG8_LDA(At, 1, 1); PG8_STAGE(PG8_SB(1, 0), b3, voffB); PG8_STAGE(PG8_SB(1, 1), b3 + hstep, voffB); PG8_STAGE(PG8_SA(1, 0), a3, voffA);
            PG8_WAIT_V(8); PG8_WAIT_L(0); PG8_BAR; PG8_MMA(1, 0, At, B0); PG8_MMA(1, 1, At, B1); PG8_BAR; PG8_SCHED;
            } else {
            PG8_LDB(B0, 0, 0); PG8_SCHED; PG8_LDA(At, 0, 0); PG8_STAGE(PG8_SA(1, 1), a1 + hstep, voffA);
            PG8_WAIT_L(8); PG8_BAR; PG8_WAIT_L(0); PG8_MMA(0, 0, At, B0); PG8_BAR; PG8_SCHED;
            PG8_LDB(B1, 0, 1); PG8_STAGE(PG8_SB(0, 0), b2, voffB);
            PG8_BAR; PG8_WAIT_L(0); PG8_MMA(0, 1, At, B1); PG8_BAR;
            PG8_LDA(At, 0, 1); PG8_STAGE(PG8_SA(0, 0), a2, voffA);
            PG8_BAR; PG8_WAIT_L(0); PG8_MMA(1, 0, At, B0); PG8_BAR; PG8_SCHED;
            PG8_STAGE(PG8_SB(0, 1), b2 + hstep, voffB);
            PG8_WAIT_V(6); PG8_BAR; PG8_MMA(1, 1, At, B1); PG8_BAR;
            PG8_LDB(B0, 1, 0); PG8_SCHED; PG8_LDA(At, 1, 0); PG8_STAGE(PG8_SA(0, 1), a2 + hstep, voffA);
            PG8_WAIT_L(8); PG8_BAR; PG8_WAIT_L(0); PG8_MMA(0, 0, At, B0); PG8_BAR; PG8_SCHED;
            PG8_LDB(B1, 1, 1); PG8_STAGE(PG8_SB(1, 0), b3, voffB);
            PG8_BAR; PG8_WAIT_L(0); PG8_MMA(0, 1, At, B1); PG8_BAR;
            PG8_LDA(At, 1, 1); PG8_STAGE(PG8_SA(1, 0), a3, voffA);
            PG8_BAR; PG8_WAIT_L(0); PG8_MMA(1, 0, At, B0); PG8_BAR; PG8_SCHED;
            PG8_STAGE(PG8_SB(1, 1), b3 + hstep, voffB);
            PG8_WAIT_V(6); PG8_BAR; PG8_MMA(1, 1, At, B1); PG8_BAR;
            }
        }
        if constexpr (ALIGN_EPI) { if (wr == 0) PG8_BAR; }
        E(acc, cur, wr, wc, fr, fq); S.done(cur);
        if (!has_next) break;
#pragma unroll
        for (int a = 0; a < 2; ++a)
#pragma unroll
            for (int b = 0; b < 2; ++b)
#pragma unroll
                for (int m = 0; m < 4; ++m)
#pragma unroll
                    for (int n = 0; n < 2; ++n) acc[a][b][m][n] = (f32x4){0.f, 0.f, 0.f, 0.f};
        cur = nxt; cA = nA; cB = nB; ++ui;
        if constexpr (ALIGN_EPI) { if (wr == 1) PG8_BAR; }
    }
    PG8_WAIT_V(0);
    if constexpr (!ALIGN_EPI) { if (wr == 0) PG8_BAR; }
    PG8_BAR;
#undef PG8_SA
#undef PG8_SB
#undef PG8_STAGE
#undef PG8_LDA
#undef PG8_LDB
#undef PG8_MMA
#undef PG8_WAIT_V
#undef PG8_WAIT_L
#undef PG8_BAR
#undef PG8_SCHED
}
}

#define XB_TMO      128
#define XB_XCNT(j)  (256  + 64 * (j))
#define XB_XSUB(j)  (1280 + 64 * (j))
#define XB_XGEN(j)  (2304 + 64 * (j))
#define XB_TOP      3328
#define XB_TOPGEN   3392
#define XCD_BAR_WORDS 3456
#define XB_SPIN_CAP (1u << 18)

__device__ __forceinline__ unsigned xb_ld(unsigned* p)              { return __hip_atomic_load(p, __ATOMIC_RELAXED, __HIP_MEMORY_SCOPE_AGENT); }
__device__ __forceinline__ unsigned xb_add(unsigned* p, unsigned v) { return __hip_atomic_fetch_add(p, v, __ATOMIC_RELAXED, __HIP_MEMORY_SCOPE_AGENT); }
__device__ __forceinline__ unsigned xb_xcc_id() { return (unsigned)__builtin_amdgcn_s_getreg((3 << 11) | 20) & 0xFu; }
#define XB_SPIN(cond, bar) do { unsigned _sp = 0; while (cond) { __builtin_amdgcn_s_sleep(1); \
    if ((++_sp & 255u) == 0u) { if (xb_ld(&(bar)[XB_TMO])) break; if (_sp > XB_SPIN_CAP) { atomicAdd(&(bar)[XB_TMO], 1u); break; } } } } while (0)

struct XcdBarrier {
    unsigned* bar; unsigned x;
    volatile LAS unsigned* st;
};

__device__ __forceinline__ XcdBarrier xcd_barrier_post(unsigned* bar, volatile LAS unsigned* st) {
    XcdBarrier b; b.bar = bar; b.x = xb_xcc_id(); b.st = st;
    if (threadIdx.x == 0) (void)xb_add(&bar[XB_XCNT(b.x)], 1u);
    return b;
}
__device__ __forceinline__ void xcd_barrier_complete(unsigned* bar, unsigned x, unsigned& nloc, unsigned& nx) {
    const unsigned G = gridDim.x * gridDim.y * gridDim.z;
    unsigned sum, cnt, mine, sp = 0u;
    for (;;) {
        sum = 0u; cnt = 0u; mine = 0u;
#pragma unroll
        for (unsigned j = 0; j < 16; ++j) { const unsigned c = xb_ld(&bar[XB_XCNT(j)]); sum += c; cnt += (c > 0u) ? 1u : 0u; mine = (j == x) ? c : mine; }
        if (sum == G) break;
        __builtin_amdgcn_s_sleep(1);
        if ((++sp & 255u) == 0u) { if (xb_ld(&bar[XB_TMO])) break; if (sp > XB_SPIN_CAP) { atomicAdd(&bar[XB_TMO], 1u); break; } }
    }
    nloc = mine > 0u ? mine : 1u; nx = cnt > 0u ? cnt : 1u;
}

__device__ __forceinline__ void xcd_barrier(const XcdBarrier& b) {
    asm volatile("s_waitcnt vmcnt(0)" ::: "memory");
    __syncthreads();
    if (threadIdx.x == 0) {
        unsigned* bar = b.bar;
        __builtin_amdgcn_s_waitcnt(0);
        unsigned nloc = b.st[0], nx = b.st[1];
        if (nloc == 0u) { xcd_barrier_complete(bar, b.x, nloc, nx); b.st[0] = nloc; b.st[1] = nx; }
        const unsigned old = xb_add(&bar[XB_XSUB(b.x)], 1u);
        const unsigned gen = old / nloc;
        if (old + 1u == (gen + 1u) * nloc) {
            __builtin_amdgcn_fence(__ATOMIC_RELEASE, "agent");
            asm volatile("s_waitcnt vmcnt(0)" ::: "memory");
            const unsigned og = xb_add(&bar[XB_TOP], 1u);
            const unsigned tg = og / nx;
            if (og + 1u == (tg + 1u) * nx) xb_add(&bar[XB_TOPGEN], 1u);
            else XB_SPIN(xb_ld(&bar[XB_TOPGEN]) == tg, bar);
            __builtin_amdgcn_fence(__ATOMIC_ACQUIRE, "agent");
            xb_add(&bar[XB_XGEN(b.x)], 1u);
            asm volatile("s_waitcnt vmcnt(0)" ::: "memory");
        } else {
            XB_SPIN(xb_ld(&bar[XB_XGEN(b.x)]) == gen, bar);
            __builtin_amdgcn_fence(__ATOMIC_ACQUIRE, "agent");
            asm volatile("s_waitcnt vmcnt(0)" ::: "memory");
        }
    }
    __syncthreads();
}

struct Args { const float* in[15]; float* out; unsigned char* ws; };

#define TIDS int tid = threadIdx.x; asm volatile("" : "+v"(tid)); const int lane = tid & 63, wave = __builtin_amdgcn_readfirstlane(tid >> 6); (void)lane; (void)wave
struct Ctx {
    LAS unsigned char* lds;
    int G, bid, vcu;
    const float* in[15]; float* out; unsigned char* ws;
};

constexpr int W_FIRST = 16 * 192 + 32 * 32, W_ALL = 2 * (16 * 192 + 32 * 32 + 16 * 72 + 16 * 32);
__device__ __forceinline__ void transpose_item(const float* W, int K, int N, bf16_t* WT, LAS float* scr, int item, int lane) {
    const int nblk = N / 32, kb = item / nblk, nb = item % nblk, k0 = 64 * kb, n0 = 32 * nb;
#pragma unroll 8
    for (int i = 0; i < 32; ++i) { const int kk = 2 * i + (lane >> 5); scr[kk * 33 + (lane & 31)] = W[(size_t)(k0 + kk) * N + n0 + (lane & 31)]; }
    asm volatile("s_waitcnt lgkmcnt(0)" ::: "memory");
    const int c = lane & 7;
#pragma unroll
    for (int j = 0; j < 4; ++j) { const int n = (lane >> 3) + 8 * j; const LAS float* s = scr + (8 * c) * 33 + n;
        u32x4 o; o.x = cvt_pk_bf16(s[0 * 33], s[1 * 33]); o.y = cvt_pk_bf16(s[2 * 33], s[3 * 33]); o.z = cvt_pk_bf16(s[4 * 33], s[5 * 33]); o.w = cvt_pk_bf16(s[6 * 33], s[7 * 33]);
        *(u32x4*)(WT + (size_t)(n0 + n) * K + k0 + 8 * c) = o; }
    asm volatile("s_waitcnt lgkmcnt(0)" ::: "memory");
}
__device__ __forceinline__ void phase_weights(Ctx& F, int lo, int hi, int gwb, int NGW) {
    TIDS;
    LAS float* scr = (LAS float*)(F.lds + wave * 16384);
    const int gw = gwb + wave;
    constexpr int I_RI = 16 * 192, I_RO = 32 * 32, I_SI = 16 * 72, I_SO = 16 * 32, PER = I_RI + I_RO + I_SI + I_SO;
    for (int it = lo + gw; it < hi; it += NGW) {
        const int li = it / PER; int r = it % PER;
        if (r < I_RI) { transpose_item(F.in[6] + (size_t)li * D * RET_IN, D, RET_IN, (bf16_t*)(F.ws + WS_WIN_RET) + (size_t)li * RET_IN * D, scr, r, lane); continue; } r -= I_RI;
        if (r < I_RO) { transpose_item(F.in[8] + (size_t)li * RET_V * D, RET_V, D, (bf16_t*)(F.ws + WS_WOUT_RET) + (size_t)li * D * RET_V, scr, r, lane); continue; } r -= I_RO;
        if (r < I_SI) { transpose_item(F.in[10] + (size_t)li * D * SWA_IN, D, SWA_IN, (bf16_t*)(F.ws + WS_WIN_SWA) + (size_t)li * SWA_IN * D, scr, r, lane); continue; } r -= I_SI;
        transpose_item(F.in[14] + (size_t)li * D * D, D, D, (bf16_t*)(F.ws + WS_WOUT_SWA) + (size_t)li * D * D, scr, r, lane);
    }
}
__device__ __forceinline__ void phase_norm(Ctx& F, const float* xp, const float* xs, const float* g) {
    TIDS;
    bf16_t* H = (bf16_t*)(F.ws + WS_H);
    const int gw = F.bid * 8 + wave, NGW = F.G * 8;
    f32x4 gv[4];
#pragma unroll
    for (int j = 0; j < 4; ++j) gv[j] = *((const f32x4*)g + lane + 64 * j);
    for (int r0 = gw; r0 < MP + MS; r0 += 2 * NGW) {
        const int r1 = r0 + NGW; const bool has1 = r1 < MP + MS; const int r1c = has1 ? r1 : r0;
        const float* s0 = r0 < MP ? xp + (size_t)r0 * D : xs + (size_t)(r0 - MP) * D;
        const float* s1 = r1c < MP ? xp + (size_t)r1c * D : xs + (size_t)(r1c - MP) * D;
        f32x4 v[4], u[4]; float a = 0.f, b = 0.f;
#pragma unroll
        for (int j = 0; j < 4; ++j) { v[j] = __builtin_nontemporal_load((const f32x4*)s0 + lane + 64 * j); u[j] = __builtin_nontemporal_load((const f32x4*)s1 + lane + 64 * j); }
#pragma unroll
        for (int j = 0; j < 4; ++j) { a += (v[j].x * v[j].x + v[j].y * v[j].y) + (v[j].z * v[j].z + v[j].w * v[j].w); b += (u[j].x * u[j].x + u[j].y * u[j].y) + (u[j].z * u[j].z + u[j].w * u[j].w); }
#pragma unroll
        for (int o = 1; o < 64; o <<= 1) { a += __shfl_xor(a, o); b += __shfl_xor(b, o); }
        const float ra = rsqrtf(a * (1.f / D) + EPS), rb = rsqrtf(b * (1.f / D) + EPS);
        u32x2* o0 = (u32x2*)(H + (size_t)r0 * D) + lane; u32x2* o1 = (u32x2*)(H + (size_t)r1c * D) + lane;
#pragma unroll
        for (int j = 0; j < 4; ++j) { f32x4 y = v[j] * ra * gv[j]; u32x2 w; w.x = cvt_pk_bf16(y.x, y.y); w.y = cvt_pk_bf16(y.z, y.w); o0[64 * j] = w; }
        if (has1) {
#pragma unroll
            for (int j = 0; j < 4; ++j) { f32x4 y = u[j] * rb * gv[j]; u32x2 w; w.x = cvt_pk_bf16(y.x, y.y); w.y = cvt_pk_bf16(y.z, y.w); o1[64 * j] = w; }
        }
    }
}

template <int K, int RM, class EF>
__device__ __forceinline__ void small_gemm(Ctx& F, const bf16_t* A, const bf16_t* Bt, int N, EF epi) {
    TIDS;
    constexpr int KW = K / 8, PST = 68, ROWS = 16 * RM, RB = 128 / ROWS;
    const int fr = lane & 15, fq = lane >> 4, nU = (N / 64) * RB;
    LAS float* part = (LAS float*)F.lds;
    for (int u = F.G - 1 - F.bid; u < nU; u += F.G) {
        const int n0 = (u / RB) * 64, r0 = (u % RB) * ROWS;
        const bf16x8* ap = (const bf16x8*)(A + (size_t)(r0 + fr) * K + wave * KW + 8 * fq);
        const bf16x8* bp = (const bf16x8*)(Bt + (size_t)(n0 + fr) * K + wave * KW + 8 * fq);
        f32x4 acc[RM][4];
#pragma unroll
        for (int m = 0; m < RM; ++m)
#pragma unroll
            for (int n = 0; n < 4; ++n) acc[m][n] = (f32x4){0.f, 0.f, 0.f, 0.f};
#pragma unroll 2
        for (int k = 0; k < KW / 32; ++k) {
            bf16x8 a[RM], bb[4];
#pragma unroll
            for (int m = 0; m < RM; ++m) a[m] = ap[(size_t)m * 16 * K / 8 + 4 * k];
#pragma unroll
            for (int n = 0; n < 4; ++n) bb[n] = bp[(size_t)n * 16 * K / 8 + 4 * k];
#pragma unroll
            for (int m = 0; m < RM; ++m)
#pragma unroll
                for (int n = 0; n < 4; ++n) acc[m][n] = MFMA16(bb[n], a[m], acc[m][n]);
        }
        __syncthreads();
#pragma unroll
        for (int m = 0; m < RM; ++m)
#pragma unroll
            for (int n = 0; n < 4; ++n) *(LAS f32x4*)(part + (wave * ROWS + 16 * m + fr) * PST + 16 * n + 4 * fq) = acc[m][n];
        __syncthreads();
#pragma unroll
        for (int q = 0; q < (ROWS * 16) / 512; ++q) {
            const int g = q * 512 + tid, row = g >> 4, c4 = (g & 15) * 4;
            f32x4 sm = {0.f, 0.f, 0.f, 0.f};
#pragma unroll
            for (int w8 = 0; w8 < 8; ++w8) sm += *(LAS f32x4*)(part + (w8 * ROWS + row) * PST + c4);
            epi(r0 + row, n0 + c4, sm);
        }
    }
}

constexpr int PK_STRIDE = 528;
__device__ __forceinline__ void ret_P_item(Ctx& F, int item) {
    TIDS;
    const bf16_t* PROJ = (const bf16_t*)(F.ws + WS_PROJ); bf16_t* P = (bf16_t*)(F.ws + WS_P) + (size_t)item * 16384;
    const int b = item >> 7, h = (item >> 5) & 3, c = item & 31, fr = lane & 15, fq = lane >> 4, w = wave;
    const int tile_ = (b * 32 + c) * 4 + h;
    const float l2g = log2f(1.f - exp2f(-5.f - (float)h));
    LAS unsigned char* KL = F.lds;
    u32x4 kreg[8]; bf16x8 qreg[8];
#pragma unroll
    for (int i = 0; i < 8; ++i) kreg[i] = *((const u32x4*)((const bf16_t*)(F.ws + WS_KB) + (size_t)tile_ * 32768) + i * 512 + tid);
    const bf16x8* qp = (const bf16x8*)((const bf16_t*)(F.ws + WS_QB) + (size_t)tile_ * 32768 + (16 * w + fr) * 256 + 8 * fq);
#pragma unroll
    for (int ks = 0; ks < 8; ++ks) qreg[ks] = qp[4 * ks];
    __syncthreads();
#pragma unroll
    for (int i = 0; i < 8; ++i) { const int cid = i * 512 + tid, s_ = cid >> 5, ch = cid & 31; *(LAS u32x4*)(KL + s_ * PK_STRIDE + 16 * ch) = kreg[i]; }
    __syncthreads();
    f32x4 acc[8];
#pragma unroll
    for (int n = 0; n < 8; ++n) acc[n] = (f32x4){0.f, 0.f, 0.f, 0.f};
#pragma unroll
    for (int ks = 0; ks < 8; ++ks) {
#pragma unroll
        for (int n = 0; n < 8; ++n) if (n <= w) { const bf16x8 k = *(const LAS bf16x8*)(KL + (16 * n + fr) * PK_STRIDE + (32 * ks + 8 * fq) * 2); acc[n] = MFMA16(k, qreg[ks], acc[n]); }
    }
    const int t = 16 * w + fr;
#pragma unroll
    for (int n = 0; n < 8; ++n) {
        float v[4];
#pragma unroll
        for (int r = 0; r < 4; ++r) { const int s_ = 16 * n + 4 * fq + r; v[r] = (t >= s_) ? acc[n][r] * exp2f(l2g * (float)(t - s_)) : 0.f; }
        u32x2 o; o.x = cvt_pk_bf16(v[0], v[1]); o.y = cvt_pk_bf16(v[2], v[3]);
        *(u32x2*)(P + t * 128 + 16 * n + 4 * fq) = o;
    }
}
__device__ __forceinline__ void ret_sample_item(Ctx& F, int li, int item) {
    TIDS;
    const bf16_t* PROJ = (const bf16_t*)(F.ws + WS_PROJ); bf16_t* O = (bf16_t*)(F.ws + WS_O);
    const int b = item >> 2, h = item & 3;
    LAS float* qk = (LAS float*)F.lds;
    LAS float* red = (LAS float*)F.lds + 512;
    const bf16_t* row = PROJ + (size_t)(MP + b) * RET_IN;
    __syncthreads();
    qk[tid] = bf2f(row[(tid < 256 ? 0 : 1024 - 256) + h * 256 + tid]);
    __syncthreads();
    const int eq = tid & 127, dg = tid >> 7;
    const float gam = 1.f - exp2f(-5.f - (float)h);
    const u32x2 vraw = *(const u32x2*)(row + 2048 + h * 512 + 4 * eq);
    const f32x4 v4 = {bf_lo(vraw.x), bf_hi(vraw.x), bf_lo(vraw.y), bf_hi(vraw.y)};
    const size_t sbase = ((size_t)(li * 128 + b) * 4 + h) * 131072;
    const f32x4* Sin = (const f32x4*)(F.in[2] + sbase) + eq; f32x4* Sout = (f32x4*)(F.out + O_RETS + sbase) + eq;
    f32x4 o4 = {0.f, 0.f, 0.f, 0.f};
    {
        f32x4 buf[16];
        const f32x4* Sr = Sin + (size_t)dg * 64 * 128; f32x4* Sw = Sout + (size_t)dg * 64 * 128;
#pragma unroll
        for (int i = 0; i < 16; ++i) buf[i] = __builtin_nontemporal_load(Sr + i * 128);
#pragma unroll
        for (int i = 0; i < 64; ++i) {
            const int d = dg * 64 + i;
            const f32x4 sn = buf[i & 15] * gam + v4 * qk[256 + d];
            if (i + 16 < 64) buf[i & 15] = __builtin_nontemporal_load(Sr + (i + 16) * 128);
            __builtin_nontemporal_store(sn, Sw + i * 128);
            o4 += sn * qk[d];
        }
    }
    *(LAS f32x4*)(red + dg * 512 + 4 * eq) = o4;
    __syncthreads();
    if (tid < 128) {
        f32x4 s = *(LAS f32x4*)(red + 4 * tid) + *(LAS f32x4*)(red + 512 + 4 * tid) + *(LAS f32x4*)(red + 1024 + 4 * tid) + *(LAS f32x4*)(red + 1536 + 4 * tid);
        u32x2 o; o.x = cvt_pk_bf16(s.x, s.y); o.y = cvt_pk_bf16(s.z, s.w);
        *(u32x2*)(O + (size_t)(MP + b) * RET_V + h * 512 + 4 * tid) = o;
    }
}
constexpr int KL_STRIDE = 544, KL_OFF = 0, VL_STRIDE = 144, VL_OFF = 69632, VDL_OFF = 88064, STL_OFF = 106496, STL_STRIDE = 528;
__device__ __forceinline__ void ret_scan_item(Ctx& F, int li, int item) {
    TIDS;
    bf16_t* O = (bf16_t*)(F.ws + WS_O);
    const int b = item >> 5, h = (item >> 3) & 3, es = item & 7, e0 = es * 64;
    const int fr = lane & 15, fq = lane >> 4, q4 = fr >> 2, p4 = fr & 3;
    const float l2g = log2f(1.f - exp2f(-5.f - (float)h));
    LAS unsigned char* KL = F.lds + KL_OFF; LAS unsigned char* VL = F.lds + VL_OFF; LAS unsigned char* VDL = F.lds + VDL_OFF; LAS unsigned char* STL = F.lds + STL_OFF;
    const size_t tokb = (size_t)b * SEQ;
    const bf16_t* QBp = (const bf16_t*)(F.ws + WS_QB); const bf16_t* KBp = (const bf16_t*)(F.ws + WS_KB); const bf16_t* VBp = (const bf16_t*)(F.ws + WS_VB);
    const int tileb = (b * 32) * 4 + h;
    __syncthreads();
    for (int i = tid; i < 64 * STL_STRIDE / 4; i += 512) ((LAS unsigned*)STL)[i] = 0u;
    if (wave < 4) {
        const int t0 = 16 * wave + fr, t1 = 16 * (7 - wave) + fr, dT = t1 - t0;
        const float cross0 = exp2f(l2g * (float)(t0 + 1)), cross1 = exp2f(l2g * (float)(t1 + 1));
        const bf16_t* Qb = QBp + (size_t)tileb * 32768 + t0 * 256 + 8 * fq;
        bf16x8 qreg[2][8];
#pragma unroll
        for (int tt = 0; tt < 2; ++tt) {
#pragma unroll
            for (int ks = 0; ks < 8; ++ks) qreg[tt][ks] = *(const bf16x8*)(Qb + tt * dT * 256 + 32 * ks);
        }
        const float gt0 = exp2f(l2g * (float)t0), gt1 = exp2f(l2g * (float)t1);
        float gsr[4], gn[8];
#pragma unroll
        for (int r = 0; r < 4; ++r) gsr[r] = exp2f(-l2g * (float)(4 * fq + r));
#pragma unroll
        for (int n = 0; n < 8; ++n) gn[n] = exp2f(-l2g * (float)(16 * n));
        const int nmax0 = wave, nmax1 = 7 - wave;
#pragma unroll 1
        for (int c = 0; c < 32; ++c) {
            LDS_BARRIER();
            f32x4 aS[2][4];
#pragma unroll
            for (int tt = 0; tt < 2; ++tt)
#pragma unroll
                for (int e = 0; e < 4; ++e) aS[tt][e] = (f32x4){0.f, 0.f, 0.f, 0.f};
#pragma unroll
            for (int ks = 0; ks < 8; ++ks) {
#pragma unroll
                for (int e = 0; e < 4; ++e) {
                    const bf16x8 sf = *(const LAS bf16x8*)(STL + (16 * e + fr) * STL_STRIDE + (32 * ks + 8 * fq) * 2);
                    aS[0][e] = MFMA16(sf, qreg[0][ks], aS[0][e]); aS[1][e] = MFMA16(sf, qreg[1][ks], aS[1][e]);
                }
            }
            bf16x8 pf[2][4];
            {
                f32x4 pa[2][8];
#pragma unroll
                for (int tt = 0; tt < 2; ++tt)
#pragma unroll
                    for (int n = 0; n < 8; ++n) pa[tt][n] = (f32x4){0.f, 0.f, 0.f, 0.f};
#pragma unroll
                for (int ks = 0; ks < 8; ++ks) {
#pragma unroll
                    for (int n = 0; n < 8; ++n) if (n <= nmax1) {
                        const bf16x8 kfr = *(const LAS bf16x8*)(KL + (16 * n + fr) * KL_STRIDE + (32 * ks + 8 * fq) * 2);
                        if (n <= nmax0) pa[0][n] = MFMA16(kfr, qreg[0][ks], pa[0][n]);
                        pa[1][n] = MFMA16(kfr, qreg[1][ks], pa[1][n]);
                    }
                }
                const int cn = c < 31 ? c + 1 : 31;
#pragma unroll
                for (int tt = 0; tt < 2; ++tt) {
#pragma unroll
                    for (int ks = 0; ks < 8; ++ks) qreg[tt][ks] = *(const bf16x8*)(Qb + (size_t)cn * 4 * 32768 + tt * dT * 256 + 32 * ks);
                }
                float gt0l = gt0, gt1l = gt1; int t0l = t0;
                asm volatile("" : "+v"(gt0l), "+v"(gt1l), "+v"(t0l));
#pragma unroll
                for (int tt = 0; tt < 2; ++tt) {
                    const int t = t0l + tt * dT; const float gt = tt ? gt1l : gt0l;
#pragma unroll
                    for (int n = 0; n < 8; ++n)
#pragma unroll
                        for (int r = 0; r < 4; ++r) { const int s_ = 16 * n + 4 * fq + r; pa[tt][n][r] = (t >= s_) ? pa[tt][n][r] * (gt * gn[n] * gsr[r]) : 0.f; }
#pragma unroll
                    for (int kk = 0; kk < 4; ++kk) pf[tt][kk] = pack8(pa[tt][2 * kk][0], pa[tt][2 * kk][1], pa[tt][2 * kk][2], pa[tt][2 * kk][3], pa[tt][2 * kk + 1][0], pa[tt][2 * kk + 1][1], pa[tt][2 * kk + 1][2], pa[tt][2 * kk + 1][3]);
                }
            }
            f32x4 aP[2][4];
#pragma unroll
            for (int tt = 0; tt < 2; ++tt)
#pragma unroll
                for (int e = 0; e < 4; ++e) aP[tt][e] = (f32x4){0.f, 0.f, 0.f, 0.f};
#pragma unroll
            for (int kk = 0; kk < 4; ++kk) if (2 * kk <= nmax1) {
#pragma unroll
                for (int e = 0; e < 4; ++e) {
                    const LAS unsigned char* a0 = VL + (32 * kk + 4 * fq + q4) * VL_STRIDE + (16 * e + 4 * p4) * 2;
                    const bf16x8 vf = cat8(tr_read(a0), tr_read(a0 + 16 * VL_STRIDE));
                    if (2 * kk <= nmax0) aP[0][e] = MFMA16(vf, pf[0][kk], aP[0][e]);
                    aP[1][e] = MFMA16(vf, pf[1][kk], aP[1][e]);
                }
            }
            const size_t tok0 = tokb + c * 128;
#pragma unroll
            for (int tt = 0; tt < 2; ++tt)
#pragma unroll
                for (int e = 0; e < 4; ++e) {
                    const f32x4 o = aP[tt][e] + aS[tt][e] * (tt ? cross1 : cross0);
                    u32x2 ow; ow.x = cvt_pk_bf16(o[0], o[1]); ow.y = cvt_pk_bf16(o[2], o[3]);
                    *(u32x2*)(O + (tok0 + t0 + tt * dT) * RET_V + h * 512 + e0 + 16 * e + 4 * fq) = ow;
                }
            LDS_BARRIER();
        }
    } else {
        const int gwv = wave - 4, gtid = tid - 256;
        const float cdec = exp2f(l2g * 128.f);
        f32x4 S[4][4];
#pragma unroll
        for (int a = 0; a < 4; ++a)
#pragma unroll
            for (int e = 0; e < 4; ++e) S[a][e] = (f32x4){0.f, 0.f, 0.f, 0.f};
        u32x4 kreg[16], vreg[4];
#pragma unroll
        for (int i = 0; i < 16; ++i) kreg[i] = *((const u32x4*)(KBp + (size_t)tileb * 32768) + i * 256 + gtid);
#pragma unroll
        for (int i = 0; i < 4; ++i) vreg[i] = *((const u32x4*)(VBp + ((size_t)tileb * 8 + es) * 8192) + i * 256 + gtid);
#pragma unroll 1
        for (int c = 0; c < 32; ++c) {
#pragma unroll
            for (int i = 0; i < 16; ++i) { const int cid = i * 256 + gtid, s_ = cid >> 5, ch = cid & 31; *(LAS u32x4*)(KL + s_ * KL_STRIDE + 16 * ch) = kreg[i]; }
#pragma unroll
            for (int i = 0; i < 4; ++i) { const int cid = i * 256 + gtid, s_ = cid >> 3, ch = cid & 7;
              *(LAS u32x4*)(VL + s_ * VL_STRIDE + 16 * ch) = vreg[i];
              const float dk = exp2f(l2g * (float)(127 - s_));
              u32x4 vd; vd.x = cvt_pk_bf16(bf_lo(vreg[i].x) * dk, bf_hi(vreg[i].x) * dk); vd.y = cvt_pk_bf16(bf_lo(vreg[i].y) * dk, bf_hi(vreg[i].y) * dk);
              vd.z = cvt_pk_bf16(bf_lo(vreg[i].z) * dk, bf_hi(vreg[i].z) * dk); vd.w = cvt_pk_bf16(bf_lo(vreg[i].w) * dk, bf_hi(vreg[i].w) * dk);
              *(LAS u32x4*)(VDL + s_ * VL_STRIDE + 16 * ch) = vd; }
            LDS_BARRIER();
            const int cn = c < 31 ? c + 1 : 31;
#pragma unroll
            for (int i = 0; i < 16; ++i) kreg[i] = *((const u32x4*)(KBp + (size_t)(tileb + 4 * cn) * 32768) + i * 256 + gtid);
#pragma unroll
            for (int i = 0; i < 4; ++i) vreg[i] = *((const u32x4*)(VBp + ((size_t)(tileb + 4 * cn) * 8 + es) * 8192) + i * 256 + gtid);
#pragma unroll
            for (int a = 0; a < 4; ++a)
#pragma unroll
                for (int e = 0; e < 4; ++e) S[a][e] *= cdec;
#pragma unroll
            for (int ks = 0; ks < 4; ++ks) {
                bf16x8 kf[4], vf[4];
#pragma unroll
                for (int a = 0; a < 4; ++a) { const LAS unsigned char* a0 = KL + (32 * ks + 8 * fq + q4) * KL_STRIDE + (64 * gwv + 16 * a + 4 * p4) * 2; kf[a] = cat8(tr_read(a0), tr_read(a0 + 4 * KL_STRIDE)); }
#pragma unroll
                for (int e = 0; e < 4; ++e) { const LAS unsigned char* a0 = VDL + (32 * ks + 8 * fq + q4) * VL_STRIDE + (16 * e + 4 * p4) * 2; vf[e] = cat8(tr_read(a0), tr_read(a0 + 4 * VL_STRIDE)); }
#pragma unroll
                for (int a = 0; a < 4; ++a)
#pragma unroll
                    for (int e = 0; e < 4; ++e) S[a][e] = MFMA16(kf[a], vf[e], S[a][e]);
            }
            LDS_BARRIER();
#pragma unroll
            for (int a = 0; a < 4; ++a)
#pragma unroll
                for (int e = 0; e < 4; ++e) { u32x2 sw; sw.x = cvt_pk_bf16(S[a][e][0], S[a][e][1]); sw.y = cvt_pk_bf16(S[a][e][2], S[a][e][3]);
                    *(LAS u32x2*)(STL + (16 * e + fr) * STL_STRIDE + (64 * gwv + 16 * a + 4 * fq) * 2) = sw; }
        }
        float* So = F.out + O_RETP + ((size_t)(li * 4 + b) * 4 + h) * 131072;
#pragma unroll
        for (int a = 0; a < 4; ++a)
#pragma unroll
            for (int e = 0; e < 4; ++e)
#pragma unroll
                for (int r = 0; r < 4; ++r) So[(size_t)(64 * gwv + 16 * a + 4 * fq + r) * 512 + e0 + 16 * e + fr] = S[a][e][r];
    }
}
__device__ __forceinline__ void phase_ret_gate(Ctx& F, int li) {
    TIDS;
    const bf16_t* PROJ = (const bf16_t*)(F.ws + WS_PROJ); const bf16_t* O = (const bf16_t*)(F.ws + WS_O); bf16_t* OG = (bf16_t*)(F.ws + WS_OG);
    const float* gn = F.in[7] + (size_t)li * RET_V;
    const int gw = F.bid * 8 + wave, NGW = F.G * 8;
    f32x4 gg[4][2];
#pragma unroll
    for (int h = 0; h < 4; ++h) { gg[h][0] = *(const f32x4*)(gn + h * 512 + 8 * lane); gg[h][1] = *(const f32x4*)(gn + h * 512 + 8 * lane + 4); }
    for (int row0 = gw; row0 < MP + MS; row0 += 2 * NGW) {
        const int row1 = row0 + NGW; const bool has1 = row1 < MP + MS;
        const int rows[2] = {row0, has1 ? row1 : row0};
        u32x4 ov[2][4], gv[2][4];
#pragma unroll
        for (int q = 0; q < 2; ++q)
#pragma unroll
            for (int h = 0; h < 4; ++h) { ov[q][h] = __builtin_nontemporal_load((const u32x4*)(O + (size_t)rows[q] * RET_V + h * 512 + 8 * lane)); gv[q][h] = __builtin_nontemporal_load((const u32x4*)(PROJ + (size_t)rows[q] * RET_IN + 4096 + h * 512 + 8 * lane)); }
        float ss[2][4];
#pragma unroll
        for (int q = 0; q < 2; ++q)
#pragma unroll
            for (int h = 0; h < 4; ++h) { const float a0 = bf_lo(ov[q][h].x), a1 = bf_hi(ov[q][h].x), a2 = bf_lo(ov[q][h].y), a3 = bf_hi(ov[q][h].y), a4 = bf_lo(ov[q][h].z), a5 = bf_hi(ov[q][h].z), a6 = bf_lo(ov[q][h].w), a7 = bf_hi(ov[q][h].w);
                ss[q][h] = (a0 * a0 + a1 * a1) + (a2 * a2 + a3 * a3) + (a4 * a4 + a5 * a5) + (a6 * a6 + a7 * a7); }
#pragma unroll
        for (int o = 1; o < 64; o <<= 1) {
#pragma unroll
            for (int q = 0; q < 2; ++q)
#pragma unroll
                for (int h = 0; h < 4; ++h) ss[q][h] += __shfl_xor(ss[q][h], o); }
#pragma unroll
        for (int q = 0; q < 2; ++q) {
            if (q == 1 && !has1) break;
#pragma unroll
            for (int h = 0; h < 4; ++h) {
                const float rstd = rsqrtf(ss[q][h] * (1.f / 512.f) + EPS);
                const f32x4 g0 = gg[h][0], g1 = gg[h][1];
                const u32x4 o4 = ov[q][h], t4 = gv[q][h];
                const float y0 = bf_lo(o4.x) * rstd * g0.x * silu(bf_lo(t4.x)), y1 = bf_hi(o4.x) * rstd * g0.y * silu(bf_hi(t4.x));
                const float y2 = bf_lo(o4.y) * rstd * g0.z * silu(bf_lo(t4.y)), y3 = bf_hi(o4.y) * rstd * g0.w * silu(bf_hi(t4.y));
                const float y4 = bf_lo(o4.z) * rstd * g1.x * silu(bf_lo(t4.z)), y5 = bf_hi(o4.z) * rstd * g1.y * silu(bf_hi(t4.z));
                const float y6 = bf_lo(o4.w) * rstd * g1.z * silu(bf_lo(t4.w)), y7 = bf_hi(o4.w) * rstd * g1.w * silu(bf_hi(t4.w));
                u32x4 w; w.x = cvt_pk_bf16(y0, y1); w.y = cvt_pk_bf16(y2, y3); w.z = cvt_pk_bf16(y4, y5); w.w = cvt_pk_bf16(y6, y7);
                *(u32x4*)(OG + (size_t)rows[q] * RET_V + h * 512 + 8 * lane) = w;
            }
        }
    }
}

constexpr int AK_STRIDE = 144, AK_OFF = 0, AV_OFF = 36864;
__device__ __forceinline__ void swa_prompt_item(Ctx& F, int li, int item) {
    TIDS;
    const bf16_t* PROJ = (const bf16_t*)(F.ws + WS_PROJ); bf16_t* OG = (bf16_t*)(F.ws + WS_OG);
    const int b = item >> 6, n = (item >> 1) & 31, kvh = item & 1;
    const int g = wave, fr = lane & 15, fq = lane >> 4, q4 = fr >> 2, p4 = fr & 3;
    LAS unsigned char* KL = F.lds + AK_OFF; LAS unsigned char* VL = F.lds + AV_OFF;
    const float* qg = F.in[11] + li * 64; const float* kg = F.in[12] + li * 64;
    __syncthreads();
    {
        const int u = tid >> 1, hf = tid & 1;
        u32x4 kw[4], vw[4];
        if (n == 0 && u < 128) {
#pragma unroll
            for (int i = 0; i < 4; ++i) { kw[i] = (u32x4){0u, 0u, 0u, 0u}; vw[i] = (u32x4){0u, 0u, 0u, 0u}; }
        } else {
            const size_t tok = (size_t)b * SEQ + (n - 1) * 128 + u;
            const u32x4* kp = (const u32x4*)(PROJ + tok * SWA_IN + 1024 + kvh * 64 + 32 * hf);
            const u32x4* vp = (const u32x4*)(PROJ + tok * SWA_IN + 1152 + kvh * 64 + 32 * hf);
            float kf[32]; float ss = 0.f;
#pragma unroll
            for (int i = 0; i < 4; ++i) { const u32x4 k = kp[i]; vw[i] = vp[i];
                kf[8 * i + 0] = bf_lo(k.x); kf[8 * i + 1] = bf_hi(k.x); kf[8 * i + 2] = bf_lo(k.y); kf[8 * i + 3] = bf_hi(k.y);
                kf[8 * i + 4] = bf_lo(k.z); kf[8 * i + 5] = bf_hi(k.z); kf[8 * i + 6] = bf_lo(k.w); kf[8 * i + 7] = bf_hi(k.w); }
#pragma unroll
            for (int i = 0; i < 32; ++i) ss += kf[i] * kf[i];
            ss += __shfl_xor(ss, 1);
            const float rstd = rsqrtf(ss * (1.f / 64.f) + EPS);
#pragma unroll
            for (int i = 0; i < 32; ++i) kf[i] = kf[i] * rstd * kg[32 * hf + i];
#pragma unroll
            for (int i = 0; i < 4; ++i) { kw[i].x = cvt_pk_bf16(kf[8 * i], kf[8 * i + 1]); kw[i].y = cvt_pk_bf16(kf[8 * i + 2], kf[8 * i + 3]); kw[i].z = cvt_pk_bf16(kf[8 * i + 4], kf[8 * i + 5]); kw[i].w = cvt_pk_bf16(kf[8 * i + 6], kf[8 * i + 7]); }
            if (n == 31 && u >= 128) {
                float* ko = F.out + O_KP + (((size_t)(li * 4 + b) * 128 + (u - 128)) * 2 + kvh) * 64 + 32 * hf;
                float* vo = F.out + O_VP + (((size_t)(li * 4 + b) * 128 + (u - 128)) * 2 + kvh) * 64 + 32 * hf;
#pragma unroll
                for (int i = 0; i < 8; ++i) *(f32x4*)(ko + 4 * i) = (f32x4){kf[4 * i], kf[4 * i + 1], kf[4 * i + 2], kf[4 * i + 3]};
#pragma unroll
                for (int i = 0; i < 4; ++i) { *(f32x4*)(vo + 8 * i) = (f32x4){bf_lo(vw[i].x), bf_hi(vw[i].x), bf_lo(vw[i].y), bf_hi(vw[i].y)}; *(f32x4*)(vo + 8 * i + 4) = (f32x4){bf_lo(vw[i].z), bf_hi(vw[i].z), bf_lo(vw[i].w), bf_hi(vw[i].w)}; }
            }
        }
#pragma unroll
        for (int i = 0; i < 4; ++i) { *(LAS u32x4*)(KL + u * AK_STRIDE + 64 * hf + 16 * i) = kw[i]; *(LAS u32x4*)(VL + u * AK_STRIDE + 64 * hf + 16 * i) = vw[i]; }
    }
    __syncthreads();
    const int head = kvh * 8 + g;
    const float slope2 = exp2f(-0.5f * (float)(head + 1)) * LOG2E;
    const float sink2 = F.in[13][li * 16 + head] * LOG2E;
    float qg0[8], qg1[8];
#pragma unroll
    for (int i = 0; i < 8; ++i) { qg0[i] = qg[8 * fq + i] * (0.125f * LOG2E); qg1[i] = qg[32 + 8 * fq + i] * (0.125f * LOG2E); }
    u32x4 nq0, nq1; u32x2 ngr[4];
    {   const size_t tokn = (size_t)b * SEQ + n * 128 + fr;
        nq0 = *(const u32x4*)(PROJ + tokn * SWA_IN + head * 64 + 8 * fq); nq1 = *(const u32x4*)(PROJ + tokn * SWA_IN + head * 64 + 32 + 8 * fq);
#pragma unroll
        for (int d = 0; d < 4; ++d) ngr[d] = *(const u32x2*)(PROJ + tokn * SWA_IN + 1280 + head * 64 + 16 * d + 4 * fq); }
#pragma unroll 1
    for (int tf = 0; tf < 8; ++tf) {
        const int j = 16 * tf + fr;
        const size_t tok = (size_t)b * SEQ + n * 128 + j;
        bf16x8 qf[2];
        const u32x4 r0 = nq0, r1 = nq1; u32x2 gcur[4];
#pragma unroll
        for (int d = 0; d < 4; ++d) gcur[d] = ngr[d];
        {   const size_t tokn = tok + (tf < 7 ? 16 : 0);
            nq0 = *(const u32x4*)(PROJ + tokn * SWA_IN + head * 64 + 8 * fq); nq1 = *(const u32x4*)(PROJ + tokn * SWA_IN + head * 64 + 32 + 8 * fq);
#pragma unroll
            for (int d = 0; d < 4; ++d) ngr[d] = *(const u32x2*)(PROJ + tokn * SWA_IN + 1280 + head * 64 + 16 * d + 4 * fq); }
        {
            float q0[8] = {bf_lo(r0.x), bf_hi(r0.x), bf_lo(r0.y), bf_hi(r0.y), bf_lo(r0.z), bf_hi(r0.z), bf_lo(r0.w), bf_hi(r0.w)};
            float q1[8] = {bf_lo(r1.x), bf_hi(r1.x), bf_lo(r1.y), bf_hi(r1.y), bf_lo(r1.z), bf_hi(r1.z), bf_lo(r1.w), bf_hi(r1.w)};
            float ss = 0.f;
#pragma unroll
            for (int i = 0; i < 8; ++i) ss += q0[i] * q0[i] + q1[i] * q1[i];
            ss += __shfl_xor(ss, 16); ss += __shfl_xor(ss, 32);
            const float sc = rsqrtf(ss * (1.f / 64.f) + EPS);
#pragma unroll
            for (int i = 0; i < 8; ++i) { q0[i] *= sc * qg0[i]; q1[i] *= sc * qg1[i]; }
            qf[0] = pack8(q0[0], q0[1], q0[2], q0[3], q0[4], q0[5], q0[6], q0[7]);
            qf[1] = pack8(q1[0], q1[1], q1[2], q1[3], q1[4], q1[5], q1[6], q1[7]);
        }
        const int f0 = tf < 6 ? tf : 6;
        f32x4 sc[10];
#pragma unroll
        for (int f = 0; f < 10; ++f) {
            sc[f] = (f32x4){0.f, 0.f, 0.f, 0.f};
#pragma unroll
            for (int ks = 0; ks < 2; ++ks) { const bf16x8 kf = *(const LAS bf16x8*)(KL + (16 * (f0 + f) + fr) * AK_STRIDE + (32 * ks + 8 * fq) * 2); sc[f] = MFMA16(kf, qf[ks], sc[f]); }
        }
        float mx = sink2;
#pragma unroll
        for (int f = 0; f < 10; ++f)
#pragma unroll
            for (int r = 0; r < 4; ++r) { const int u = 16 * (f0 + f) + 4 * fq + r; const int dist = 128 + j - u;
                const bool valid = (dist >= 0) && (dist <= 128) && (n > 0 || u >= 128);
                const float s = valid ? sc[f][r] - slope2 * (float)dist : -1e30f; sc[f][r] = s; mx = fmaxf(mx, s); }
        mx = fmaxf(mx, __shfl_xor(mx, 16)); mx = fmaxf(mx, __shfl_xor(mx, 32));
        float l = 0.f;
#pragma unroll
        for (int f = 0; f < 10; ++f)
#pragma unroll
            for (int r = 0; r < 4; ++r) { const float p = __builtin_amdgcn_exp2f(sc[f][r] - mx); sc[f][r] = p; l += p; }
        l += __shfl_xor(l, 16); l += __shfl_xor(l, 32);
        l += __builtin_amdgcn_exp2f(sink2 - mx);
        const float inv = 1.f / l;
        f32x4 oa[4];
#pragma unroll
        for (int d = 0; d < 4; ++d) oa[d] = (f32x4){0.f, 0.f, 0.f, 0.f};
#pragma unroll
        for (int kk = 0; kk < 5; ++kk) {
            const bf16x8 pf = pack8(sc[2 * kk][0], sc[2 * kk][1], sc[2 * kk][2], sc[2 * kk][3], sc[2 * kk + 1][0], sc[2 * kk + 1][1], sc[2 * kk + 1][2], sc[2 * kk + 1][3]);
#pragma unroll
            for (int d = 0; d < 4; ++d) {
                const LAS unsigned char* a0 = VL + (16 * (f0 + 2 * kk) + 4 * fq + q4) * AK_STRIDE + (16 * d + 4 * p4) * 2;
                const bf16x8 vf = cat8(tr_read(a0), tr_read(a0 + 16 * AK_STRIDE));
                oa[d] = MFMA16(vf, pf, oa[d]);
            }
        }
#pragma unroll
        for (int d = 0; d < 4; ++d) {
            const u32x2 gr = gcur[d];
            const float y0 = oa[d][0] * inv * silu(bf_lo(gr.x)), y1 = oa[d][1] * inv * silu(bf_hi(gr.x)), y2 = oa[d][2] * inv * silu(bf_lo(gr.y)), y3 = oa[d][3] * inv * silu(bf_hi(gr.y));
            u32x2 ow; ow.x = cvt_pk_bf16(y0, y1); ow.y = cvt_pk_bf16(y2, y3);
            *(u32x2*)(OG + tok * D + head * 64 + 16 * d + 4 * fq) = ow;
        }
    }
}
__device__ __forceinline__ void swa_sample_item(Ctx& F, int li, int item) {
    TIDS;
    const bf16_t* PROJ = (const bf16_t*)(F.ws + WS_PROJ); bf16_t* OG = (bf16_t*)(F.ws + WS_OG);
    const int b = item >> 1, kvh = item & 1, g = wave;
    LAS float* Kf = (LAS float*)F.lds;
    LAS float* Vf = Kf + 8400;
    LAS float* pb = Vf + 129 * 64;
    LAS float* qb = pb + 8 * 136;
    const bf16_t* row = PROJ + (size_t)(MP + b) * SWA_IN;
    __syncthreads();
    {
        const int u = tid >> 2, dq = tid & 3;
        const size_t ci = (((size_t)(li * 128 + b) * 128 + u) * 2 + kvh) * 64 + 16 * dq;
        const float* kc = F.in[3] + ci; const float* vc = F.in[4] + ci;
#pragma unroll
        for (int i = 0; i < 4; ++i) {
            const f32x4 k = *(const f32x4*)(kc + 4 * i), v = *(const f32x4*)(vc + 4 * i);
            Kf[u * 65 + 16 * dq + 4 * i + 0] = k.x; Kf[u * 65 + 16 * dq + 4 * i + 1] = k.y; Kf[u * 65 + 16 * dq + 4 * i + 2] = k.z; Kf[u * 65 + 16 * dq + 4 * i + 3] = k.w;
            *(LAS f32x4*)(Vf + u * 64 + 16 * dq + 4 * i) = v;
            if (u >= 1) { const size_t oi = (((size_t)(li * 128 + b) * 128 + (u - 1)) * 2 + kvh) * 64 + 16 * dq + 4 * i; *(f32x4*)(F.out + O_KS + oi) = k; *(f32x4*)(F.out + O_VS + oi) = v; }
        }
    }
    if (g == 0) {
        const float k = bf2f(row[1024 + kvh * 64 + lane]);
        const float kn = k * rsqrtf(wave_sum(k * k) * (1.f / 64.f) + EPS) * F.in[12][li * 64 + lane];
        Kf[128 * 65 + lane] = kn;
        F.out[O_KS + (((size_t)(li * 128 + b) * 128 + 127) * 2 + kvh) * 64 + lane] = kn;
    } else if (g == 1) {
        const float v = bf2f(row[1152 + kvh * 64 + lane]);
        Vf[128 * 64 + lane] = v;
        F.out[O_VS + (((size_t)(li * 128 + b) * 128 + 127) * 2 + kvh) * 64 + lane] = v;
    }
    const int head = kvh * 8 + g;
    {
        const float q = bf2f(row[head * 64 + lane]);
        qb[g * 64 + lane] = q * rsqrtf(wave_sum(q * q) * (1.f / 64.f) + EPS) * F.in[11][li * 64 + lane] * 0.125f;
    }
    __syncthreads();
    const float slope = exp2f(-0.5f * (float)(head + 1));
    const float sink = F.in[13][li * 16 + head];
    float s0 = 0.f, s1 = 0.f, s2 = 0.f;
#pragma unroll 8
    for (int d = 0; d < 64; ++d) { const float q = qb[g * 64 + d]; s0 += q * Kf[lane * 65 + d]; s1 += q * Kf[(lane + 64) * 65 + d]; s2 += q * Kf[128 * 65 + d]; }
    s0 -= slope * (float)(128 - lane); s1 -= slope * (float)(64 - lane);
    const float mx = fmaxf(fmaxf(wave_max(fmaxf(s0, s1)), s2), sink);
    const float e0 = __expf(s0 - mx), e1 = __expf(s1 - mx), e2 = __expf(s2 - mx);
    const float l = wave_sum(e0 + e1) + e2 + __expf(sink - mx);
    pb[g * 136 + lane] = e0; pb[g * 136 + 64 + lane] = e1; if (lane == 0) pb[g * 136 + 128] = e2;
    __syncthreads();
    float o = 0.f;
#pragma unroll 8
    for (int u = 0; u < 129; ++u) o += pb[g * 136 + u] * Vf[u * 64 + lane];
    o = o / l * silu(bf2f(row[1280 + head * 64 + lane]));
    OG[(size_t)(MP + b) * D + head * 64 + lane] = (bf16_t)(cvt_pk_bf16(o, 0.f) & 0xffffu);
}

__global__ void __launch_bounds__(512, 2) hybrid_fwd(Args args) {
    extern __shared__ __attribute__((aligned(16))) unsigned char lds_raw[];
    cg::grid_group grid = cg::this_grid();
    Ctx F;
    F.lds = (LAS unsigned char*)lds_raw;
    F.G = gridDim.x; F.bid = blockIdx.x; F.vcu = (F.G % 8 == 0) ? (F.bid % 8) * (F.G / 8) + F.bid / 8 : F.bid;
#pragma unroll
    for (int i = 0; i < 15; ++i) F.in[i] = args.in[i];
    F.out = args.out; F.ws = args.ws;
    bf16_t* H = (bf16_t*)(F.ws + WS_H); bf16_t* PROJ = (bf16_t*)(F.ws + WS_PROJ); bf16_t* OG = (bf16_t*)(F.ws + WS_OG);
    volatile LAS unsigned* MISC = (volatile LAS unsigned*)(F.lds + MISC_OFF);
    if (threadIdx.x < 16) MISC[threadIdx.x] = 0u;
    if (blockIdx.x == 0) { unsigned* bw = (unsigned*)(F.ws + WS_BAR); for (int i = threadIdx.x; i < 4096; i += 512) __hip_atomic_store(bw + i, 0u, __ATOMIC_RELAXED, __HIP_MEMORY_SCOPE_AGENT); }
    __syncthreads();
#define GRID_BAR() xcd_barrier(bar)
    float* yp = F.out + O_YP; float* ys = F.out + O_YS;

    phase_weights(F, 0, W_FIRST, F.bid * 8, F.G * 8);
    phase_norm(F, F.in[0], F.in[1], F.in[5]);
    grid.sync();
    const XcdBarrier bar = xcd_barrier_post((unsigned*)(F.ws + WS_BAR), MISC + 8);

#pragma unroll 1
    for (int layer = 0; layer < 4; ++layer) {
        const int li = layer >> 1;
        const float* xp = layer == 0 ? F.in[0] : yp; const float* xs = layer == 0 ? F.in[1] : ys;
        if ((layer & 1) == 0) {
            const bf16_t* Wi = (const bf16_t*)(F.ws + WS_WIN_RET) + (size_t)li * RET_IN * D; const bf16_t* Wo = (const bf16_t*)(F.ws + WS_WOUT_RET) + (size_t)li * D * RET_V;
            {
                pg8::Gemm g{H, Wi, MP, RET_IN, D}; pg8::StaticOrder S; S.init(MP, RET_IN, F.G, F.bid);
                pg8::EpiProjRet E{(bf16_t*)(F.ws + WS_QB), (bf16_t*)(F.ws + WS_KB), (bf16_t*)(F.ws + WS_VB), PROJ, RET_IN};
                pg8::gemm_phase<pg8::EpiProjRet, pg8::StaticOrder, false, true>(F.lds, g, S, E);
                small_gemm<D, 4>(F, H + (size_t)MP * D, Wi, RET_IN, [&](int r, int c, f32x4 v) {
                    if (c >= 1024 && c < 2048) v *= 0.0625f;
                    u32x2 o; o.x = cvt_pk_bf16(v[0], v[1]); o.y = cvt_pk_bf16(v[2], v[3]); *(u32x2*)(PROJ + (size_t)(MP + r) * RET_IN + c) = o; });
            }
            GRID_BAR();
            {
                const bool x8 = (F.G % 16 == 0); const int L = x8 ? F.G / 8 : F.G, x = x8 ? F.bid % 8 : 0, j = x8 ? F.bid / 8 : F.bid, hl = L / 2;
                const int nscan = x8 ? F.G / 2 : hl, nstream = x8 ? F.G / 2 : L - hl;
                if (j < hl) { for (int it = x * hl + j; it < 128; it += nscan) ret_scan_item(F, li, it); }
                else { for (int it = x * hl + (j - hl); it < 512; it += nstream) ret_sample_item(F, li, it);
                       if (layer == 0) { __syncthreads(); phase_weights(F, W_FIRST, W_ALL, (x * hl + (j - hl)) * 8, nstream * 8); } }
            }
            GRID_BAR();
            phase_ret_gate(F, li);
            GRID_BAR();
            {
                pg8::Gemm g{OG, Wo, MP, D, RET_V}; pg8::StaticOrder S; S.init(MP, D, F.G, F.bid);
                pg8::EpiRes E{xp, yp, D};
                pg8::gemm_phase<pg8::EpiRes, pg8::StaticOrder, true, true>(F.lds, g, S, E);
                small_gemm<RET_V, 2>(F, OG + (size_t)MP * RET_V, Wo, D, [&](int r, int c, f32x4 v) {
                    const f32x4 x = *(const f32x4*)(xs + (size_t)r * D + c); *(f32x4*)(ys + (size_t)r * D + c) = x + v; });
            }
            GRID_BAR();
        } else {
            const bf16_t* Wi = (const bf16_t*)(F.ws + WS_WIN_SWA) + (size_t)li * SWA_IN * D; const bf16_t* Wo = (const bf16_t*)(F.ws + WS_WOUT_SWA) + (size_t)li * D * D;
            {
                pg8::Gemm g{H, Wi, MP, SWA_IN, D}; pg8::StaticOrder S; S.init(MP, SWA_IN, F.G, F.bid);
                pg8::EpiProj E{PROJ, SWA_IN, 0, 0, 1.f};
                pg8::gemm_phase<pg8::EpiProj, pg8::StaticOrder, false, true>(F.lds, g, S, E);
                small_gemm<D, 4>(F, H + (size_t)MP * D, Wi, SWA_IN, [&](int r, int c, f32x4 v) {
                    u32x2 o; o.x = cvt_pk_bf16(v[0], v[1]); o.y = cvt_pk_bf16(v[2], v[3]); *(u32x2*)(PROJ + (size_t)(MP + r) * SWA_IN + c) = o; });
            }
            GRID_BAR();
            for (int it = F.vcu; it < 256; it += F.G) swa_prompt_item(F, li, it);
            for (int it = F.bid; it < 256; it += F.G) swa_sample_item(F, li, it);
            GRID_BAR();
            {
                pg8::Gemm g{OG, Wo, MP, D, D}; pg8::StaticOrder S; S.init(MP, D, F.G, F.bid);
                pg8::EpiRes E{xp, yp, D};
                pg8::gemm_phase<pg8::EpiRes, pg8::StaticOrder, true, true>(F.lds, g, S, E);
                small_gemm<D, 2>(F, OG + (size_t)MP * D, Wo, D, [&](int r, int c, f32x4 v) {
                    const f32x4 x = *(const f32x4*)(xs + (size_t)r * D + c); *(f32x4*)(ys + (size_t)r * D + c) = x + v; });
            }
            GRID_BAR();
        }
        if (layer < 3) {
            const float* gnext = ((layer + 1) & 1) ? F.in[9] + (size_t)((layer + 1) >> 1) * D : F.in[5] + (size_t)((layer + 1) >> 1) * D;
            phase_norm(F, yp, ys, gnext);
            GRID_BAR();
        }
    }
}

extern "C" void kernel_launch(void* const* d_in, const int* in_sizes, int n_in, void* d_out, int out_size, void* d_ws, size_t ws_size, hipStream_t stream) {
    static int grid = 0;
    if (grid == 0) {
        if (n_in != 15 || (size_t)out_size != O_END || ws_size < WS_END) { fprintf(stderr, "kernel_launch: unexpected shapes (n_in %d out %d ws %zu)\n", n_in, out_size, ws_size); grid = -1; return; }
        int dev = 0, cus = 0, per_cu = 0;
        if (hipGetDevice(&dev) != hipSuccess || hipDeviceGetAttribute(&cus, hipDeviceAttributeMultiprocessorCount, dev) != hipSuccess) { grid = -1; return; }
        if (hipFuncSetAttribute((const void*)hybrid_fwd, hipFuncAttributeMaxDynamicSharedMemorySize, LDS_BYTES) != hipSuccess) { fprintf(stderr, "kernel_launch: hipFuncSetAttribute failed\n"); grid = -1; return; }
        if (hipOccupancyMaxActiveBlocksPerMultiprocessor(&per_cu, (const void*)hybrid_fwd, 512, LDS_BYTES) != hipSuccess || per_cu < 1) { fprintf(stderr, "kernel_launch: occupancy query failed (%d)\n", per_cu); (void)hipGetLastError(); per_cu = 1; }
        grid = cus * per_cu;
    }
    if (grid < 0) return;
    Args a{};
    for (int i = 0; i < 15; ++i) a.in[i] = (const float*)d_in[i];
    a.out = (float*)d_out; a.ws = (unsigned char*)d_ws;
    void* kargs[] = {&a};
    hipError_t e = hipLaunchCooperativeKernel((const void*)hybrid_fwd, dim3(grid), dim3(512), kargs, LDS_BYTES, stream);
    if (e != hipSuccess) fprintf(stderr, "kernel_launch: cooperative launch failed: %s (grid %d)\n", hipGetErrorString(e), grid);
}
```
